# Optimizing an MI355X kernel written in HIP

```python
import math
import jax, jax.numpy as jnp
from jax import lax
import numpy as np

D_MODEL = 1024
BATCH = 16
SEQ = 2048
DEPTH = 2

HEAD_DIM = 64
N_HEADS = D_MODEL // HEAD_DIM
A_HEADS = 4
B_HEADS = 6
C_HEADS = N_HEADS - A_HEADS - B_HEADS
A_WIDTH = A_HEADS * HEAD_DIM
B_WIDTH = B_HEADS * HEAD_DIM
C_WIDTH = C_HEADS * HEAD_DIM
A_QK_DIM = HEAD_DIM // 2
ROPE_THETA = 500000.0
ROPE_FRACTION = 4
DILATED_BRANCHES = ((128, 1), (512, 4), (2048, 16))
DENSE_Q_BLOCK = 128
MOBA_BLOCK = 256
MOBA_TOP_K = 3
MOBA_Q_CHUNK = 16
MEM_LEN = 256
MEM_HEADS = 4
MEM_HEAD_DIM = 64
MEM_WIDTH = MEM_HEADS * MEM_HEAD_DIM
D_FF = 2816
NORM_EPS = 1e-6
NEG_INF = -1e30
POS_OFFSET_MAX = 4096

kernel_name = "hymba_style_diff_dilated_moba_macaron"


def rms_norm(x, g):
    xf = x.astype(jnp.float32)
    y = xf * lax.rsqrt(jnp.mean(xf * xf, axis=-1, keepdims=True) + NORM_EPS)
    return (y * g.astype(jnp.float32)).astype(x.dtype)


def swiglu(h, w_gate, w_up, w_down):
    return (jax.nn.silu(h @ w_gate) * (h @ w_up)) @ w_down


def rotary_tables(positions, rot_dim):
    inv_freq = ROPE_THETA ** (-jnp.arange(0, rot_dim, 2, dtype=jnp.float32) / rot_dim)
    ang = positions.astype(jnp.float32)[..., None] * inv_freq
    return jnp.cos(ang), jnp.sin(ang)


def apply_partial_rotary(x, cos, sin):
    r = 2 * cos.shape[-1]
    c = cos[:, :, None, :].astype(x.dtype)
    s = sin[:, :, None, :].astype(x.dtype)
    x1, x2, xp = x[..., : r // 2], x[..., r // 2: r], x[..., r:]
    return jnp.concatenate([x1 * c - x2 * s, x2 * c + x1 * s, xp], axis=-1)


def differential_attention(q, k, v, lam, subln_g, lam_init):
    S = q.shape[1]
    dq = q.shape[-1] // 2
    scale = dq ** -0.5
    q1, q2 = q[..., :dq] * scale, q[..., dq:] * scale
    k1, k2 = k[..., :dq], k[..., dq:]
    outs = []
    for i in range(S // DENSE_Q_BLOCK):
        q_lo, q_hi = i * DENSE_Q_BLOCK, (i + 1) * DENSE_Q_BLOCK
        mask = jnp.arange(q_hi)[None, :] <= jnp.arange(q_lo, q_hi)[:, None]
        s1 = jnp.einsum('bqhd,bkhd->bhqk', q1[:, q_lo:q_hi], k1[:, :q_hi]).astype(jnp.float32)
        s2 = jnp.einsum('bqhd,bkhd->bhqk', q2[:, q_lo:q_hi], k2[:, :q_hi]).astype(jnp.float32)
        p1 = jax.nn.softmax(jnp.where(mask, s1, NEG_INF), axis=-1)
        p2 = jax.nn.softmax(jnp.where(mask, s2, NEG_INF), axis=-1)
        a = (p1 - lam * p2).astype(v.dtype)
        outs.append(jnp.einsum('bhqk,bkhd->bqhd', a, v[:, :q_hi]))
    o = jnp.concatenate(outs, axis=1)
    return rms_norm(o, subln_g) * (1.0 - lam_init)


def dilated_branch(q, k, v, window, dilation):
    B_, S, H, dh = q.shape
    L = S // dilation
    span = window // dilation
    Lp = -(-L // span) * span
    nb = Lp // span

    def to_sub(t):
        t = t.reshape(B_, L, dilation, H, dh).transpose(0, 2, 3, 1, 4)
        t = jnp.pad(t, ((0, 0), (0, 0), (0, 0), (0, Lp - L), (0, 0)))
        return t.reshape(B_, dilation, H, nb, span, dh)

    qb = to_sub(q) * dh ** -0.5
    kb, vb = to_sub(k), to_sub(v)
    prev = lambda t: jnp.pad(t, ((0, 0), (0, 0), (0, 0), (1, 0), (0, 0), (0, 0)))[:, :, :, :-1]
    kk = jnp.concatenate([prev(kb), kb], axis=4)
    vv = jnp.concatenate([prev(vb), vb], axis=4)
    s = jnp.einsum('brhnqd,brhnkd->brhnqk', qb, kk).astype(jnp.float32)
    qi = jnp.arange(span)[:, None] + span
    ki = jnp.arange(2 * span)[None, :]
    rel = qi - ki
    band = (rel >= 0) & (rel <= span)
    has_prev = (jnp.arange(nb) > 0)[:, None, None] | (ki >= span)[None]
    s = jnp.where(band[None] & has_prev, s, NEG_INF)
    lse = jax.nn.logsumexp(s, axis=-1)
    p = jnp.exp(s - lse[..., None]).astype(v.dtype)
    o = jnp.einsum('brhnqk,brhnkd->brhnqd', p, vv)
    o = o.reshape(B_, dilation, H, Lp, dh)[:, :, :, :L].transpose(0, 3, 1, 2, 4).reshape(B_, S, H, dh)
    lse = lse.reshape(B_, dilation, H, Lp)[..., :L].transpose(0, 3, 1, 2).reshape(B_, S, H)
    return o, lse


def dilated_attention(q, k, v):
    outs, lses = [], []
    for window, dilation in DILATED_BRANCHES:
        o, lse = dilated_branch(q, k, v, window, dilation)
        outs.append(o)
        lses.append(lse)
    w = jax.nn.softmax(jnp.stack(lses, axis=0), axis=0)
    o = jnp.einsum('nbsh,nbshd->bshd', w, jnp.stack(outs, axis=0).astype(jnp.float32))
    return o.astype(q.dtype)


def moba_attention(q, k, v):
    B_, S, H, dh = q.shape
    nblk = -(-S // MOBA_BLOCK)
    Sp = nblk * MOBA_BLOCK

    def prep(t):
        return jnp.pad(t, ((0, 0), (0, Sp - S), (0, 0), (0, 0))).transpose(0, 2, 1, 3)

    qh = prep(q) * dh ** -0.5
    kh, vh = prep(k), prep(v)
    qb = qh.reshape(B_, H, nblk, MOBA_BLOCK, dh)
    kb = kh.reshape(B_, H, nblk, MOBA_BLOCK, dh)
    vb = vh.reshape(B_, H, nblk, MOBA_BLOCK, dh)

    s_own = jnp.einsum('bhnqd,bhnkd->bhnqk', qb, kb).astype(jnp.float32)
    causal = jnp.tril(jnp.ones((MOBA_BLOCK, MOBA_BLOCK), dtype=bool))
    s_own = jnp.where(causal, s_own, NEG_INF)
    lse_own = jax.nn.logsumexp(s_own, axis=-1)
    o_own = jnp.einsum('bhnqk,bhnkd->bhnqd', jnp.exp(s_own - lse_own[..., None]).astype(v.dtype), vb)
    o_own = o_own.reshape(B_, H, Sp, dh)
    lse_own = lse_own.reshape(B_, H, Sp)

    k_mean = jnp.mean(kb.astype(jnp.float32), axis=3)
    gate = jnp.einsum('bhsd,bhnd->bhsn', qh.astype(jnp.float32), k_mean)
    q_blk = jnp.arange(Sp) // MOBA_BLOCK
    is_past = jnp.arange(nblk)[None, :] < q_blk[:, None]
    gate = jnp.where(is_past, gate, -jnp.inf)
    n_sel = min(MOBA_TOP_K, nblk)
    _, sel = lax.top_k(gate, n_sel)
    sel_ok = sel < q_blk[:, None]

    n_chunks = Sp // MOBA_Q_CHUNK

    def chunks(t):
        return jnp.moveaxis(t.reshape(B_, H, n_chunks, MOBA_Q_CHUNK, *t.shape[3:]), 2, 0)

    bi = jnp.arange(B_)[:, None, None, None]
    hi = jnp.arange(H)[None, :, None, None]

    def attend_selected(args):
        qc, sc, okc = args
        kg = kb[bi, hi, sc]
        vg = vb[bi, hi, sc]
        s = jnp.einsum('bhqd,bhqnkd->bhqnk', qc, kg).astype(jnp.float32)
        s = jnp.where(okc[..., None], s, NEG_INF).reshape(B_, H, MOBA_Q_CHUNK, n_sel * MOBA_BLOCK)
        lse = jax.nn.logsumexp(s, axis=-1)
        p = jnp.exp(s - lse[..., None]).reshape(B_, H, MOBA_Q_CHUNK, n_sel, MOBA_BLOCK)
        o = jnp.einsum('bhqnk,bhqnkd->bhqd', p.astype(vg.dtype), vg)
        return o, lse

    o_sel, lse_sel = lax.map(attend_selected, (chunks(qh), chunks(sel), chunks(sel_ok)))
    o_sel = jnp.moveaxis(o_sel, 0, 2).reshape(B_, H, Sp, dh)
    lse_sel = jnp.moveaxis(lse_sel, 0, 2).reshape(B_, H, Sp)

    m = jnp.maximum(lse_own, lse_sel)
    w_own = jnp.exp(lse_own - m)[..., None]
    w_sel = jnp.exp(lse_sel - m)[..., None]
    o = (w_own * o_own.astype(jnp.float32) + w_sel * o_sel.astype(jnp.float32)) / (w_own + w_sel)
    return o.astype(q.dtype).transpose(0, 2, 1, 3)[:, :S]


def memory_cross_attention(h, m, w_q, w_kv, w_o):
    B_, S, _ = h.shape
    M = m.shape[1]
    q = (h @ w_q).reshape(B_, S, MEM_HEADS, MEM_HEAD_DIM) * MEM_HEAD_DIM ** -0.5
    kv = (m @ w_kv).reshape(B_, M, 2, MEM_HEADS, MEM_HEAD_DIM)
    k, v = kv[:, :, 0], kv[:, :, 1]
    s = jnp.einsum('bshd,bmhd->bhsm', q, k).astype(jnp.float32)
    p = jax.nn.softmax(s, axis=-1).astype(v.dtype)
    o = jnp.einsum('bhsm,bmhd->bshd', p, v).reshape(B_, S, MEM_WIDTH)
    return o @ w_o


def setup_inputs(seed: int = 0) -> dict:
    key = jax.random.key(seed)
    ks = iter(jax.random.split(key, 40))
    L, D, F = DEPTH, D_MODEL, D_FF

    def nrm(shape, fan_in):
        return jax.random.normal(next(ks), shape, jnp.float32) * fan_in ** -0.5

    def gain(shape):
        return 1.0 + 0.01 * jax.random.normal(next(ks), shape, jnp.float32)

    x = jax.random.normal(next(ks), (BATCH, SEQ, D), jnp.float32)
    mem = jax.random.normal(next(ks), (BATCH, MEM_LEN, D), jnp.float32)
    positions = (jnp.arange(SEQ, dtype=jnp.int32)[None, :]
                 + jax.random.randint(next(ks), (BATCH, 1), 0, POS_OFFSET_MAX, dtype=jnp.int32))
    return {
        "x": x,
        "mem": mem,
        "positions": positions,
        "ffn1_norm": gain((L, D)),
        "ffn1_w_gate": nrm((L, D, F), D),
        "ffn1_w_up": nrm((L, D, F), D),
        "ffn1_w_down": nrm((L, F, D), F),
        "mix_norm": gain((L, D)),
        "w_in": nrm((L, D, 3 * D), D),
        "w_out": nrm((L, D, D), D),
        "diff_lambda_q1": 0.1 * jax.random.normal(next(ks), (L, A_QK_DIM), jnp.float32),
        "diff_lambda_k1": 0.1 * jax.random.normal(next(ks), (L, A_QK_DIM), jnp.float32),
        "diff_lambda_q2": 0.1 * jax.random.normal(next(ks), (L, A_QK_DIM), jnp.float32),
        "diff_lambda_k2": 0.1 * jax.random.normal(next(ks), (L, A_QK_DIM), jnp.float32),
        "diff_subln": gain((L, HEAD_DIM)),
        "memq_norm": gain((L, D)),
        "memkv_norm": gain((L, D)),
        "mem_w_q": nrm((L, D, MEM_WIDTH), D),
        "mem_w_kv": nrm((L, D, 2 * MEM_WIDTH), D),
        "mem_w_o": nrm((L, MEM_WIDTH, D), MEM_WIDTH),
        "ffn2_norm": gain((L, D)),
        "ffn2_w_gate": nrm((L, D, F), D),
        "ffn2_w_up": nrm((L, D, F), D),
        "ffn2_w_down": nrm((L, F, D), F),
        "final_norm": gain((D,)),
    }


def reference(x, mem, positions, ffn1_norm, ffn1_w_gate, ffn1_w_up, ffn1_w_down, mix_norm, w_in, w_out,
              diff_lambda_q1, diff_lambda_k1, diff_lambda_q2, diff_lambda_k2, diff_subln,
              memq_norm, memkv_norm, mem_w_q, mem_w_kv, mem_w_o,
              ffn2_norm, ffn2_w_gate, ffn2_w_up, ffn2_w_down, final_norm):
    B_, S, D = x.shape
    cos_a, sin_a = rotary_tables(positions, A_QK_DIM // ROPE_FRACTION)
    cos_h, sin_h = rotary_tables(positions, HEAD_DIM // ROPE_FRACTION)
    widths = (A_WIDTH, A_WIDTH, A_WIDTH, B_WIDTH, B_WIDTH, B_WIDTH, C_WIDTH, C_WIDTH, C_WIDTH)
    split_at = [sum(widths[:i + 1]) for i in range(len(widths) - 1)]

    for l in range(DEPTH):
        lam_init = 0.8 - 0.6 * math.exp(-0.3 * l)

        x = x + 0.5 * swiglu(rms_norm(x, ffn1_norm[l]), ffn1_w_gate[l], ffn1_w_up[l], ffn1_w_down[l])

        h = rms_norm(x, mix_norm[l])
        qa, ka, va, qb, kb, vb, qc, kc, vc = jnp.split(h @ w_in[l], split_at, axis=-1)

        qa = apply_partial_rotary(qa.reshape(B_, S, 2 * A_HEADS, A_QK_DIM), cos_a, sin_a).reshape(B_, S, A_HEADS, HEAD_DIM)
        ka = apply_partial_rotary(ka.reshape(B_, S, 2 * A_HEADS, A_QK_DIM), cos_a, sin_a).reshape(B_, S, A_HEADS, HEAD_DIM)
        va = va.reshape(B_, S, A_HEADS, HEAD_DIM)
        lam = (jnp.exp(jnp.sum(diff_lambda_q1[l].astype(jnp.float32) * diff_lambda_k1[l].astype(jnp.float32)))
               - jnp.exp(jnp.sum(diff_lambda_q2[l].astype(jnp.float32) * diff_lambda_k2[l].astype(jnp.float32)))
               + lam_init)
        o_a = differential_attention(qa, ka, va, lam, diff_subln[l], lam_init)

        qb = apply_partial_rotary(qb.reshape(B_, S, B_HEADS, HEAD_DIM), cos_h, sin_h)
        kb = apply_partial_rotary(kb.reshape(B_, S, B_HEADS, HEAD_DIM), cos_h, sin_h)
        o_b = dilated_attention(qb, kb, vb.reshape(B_, S, B_HEADS, HEAD_DIM))

        qc = apply_partial_rotary(qc.reshape(B_, S, C_HEADS, HEAD_DIM), cos_h, sin_h)
        kc = apply_partial_rotary(kc.reshape(B_, S, C_HEADS, HEAD_DIM), cos_h, sin_h)
        o_c = moba_attention(qc, kc, vc.reshape(B_, S, C_HEADS, HEAD_DIM))

        mixed = jnp.concatenate([o_a.reshape(B_, S, A_WIDTH), o_b.reshape(B_, S, B_WIDTH),
                                 o_c.reshape(B_, S, C_WIDTH)], axis=-1)
        x = x + mixed @ w_out[l]

        x = x + memory_cross_attention(rms_norm(x, memq_norm[l]), rms_norm(mem, memkv_norm[l]),
                                       mem_w_q[l], mem_w_kv[l], mem_w_o[l])

        x = x + 0.5 * swiglu(rms_norm(x, ffn2_norm[l]), ffn2_w_gate[l], ffn2_w_up[l], ffn2_w_down[l])

    return rms_norm(x, final_norm)
```

```cpp
#include <hip/hip_runtime.h>
#include <hip/hip_cooperative_groups.h>
#include <cstdio>
#include <cstdint>
namespace cg = cooperative_groups;

#define DI __device__ __forceinline__
#define LAS __attribute__((address_space(3)))
typedef unsigned short bf16_t;
typedef short bf16x8 __attribute__((ext_vector_type(8)));
typedef short s16x4 __attribute__((ext_vector_type(4)));
typedef float f32x4 __attribute__((ext_vector_type(4)));
typedef float f32x2 __attribute__((ext_vector_type(2)));
typedef float f32x16 __attribute__((ext_vector_type(16)));
typedef unsigned u32x4 __attribute__((ext_vector_type(4)));
typedef unsigned u32x2 __attribute__((ext_vector_type(2)));
typedef __bf16 bf2_t __attribute__((ext_vector_type(2)));

constexpr int BATCH = 16, SEQ = 2048, D = 1024, MTOK = BATCH * SEQ, FF = 2816, MEMLEN = 256, MROWS = BATCH * MEMLEN, NQKV = 3072;
constexpr int COL_QA = 0, COL_KA = 256, COL_VA = 512, COL_QB = 768, COL_KB = 1152, COL_VB = 1536, COL_QC = 1920, COL_KC = 2304, COL_VC = 2688;
constexpr float EPS = 1e-6f;
constexpr float LOG2E = 1.4426950408889634f;

constexpr size_t MiB = 1u << 20;
constexpr size_t WS_MISC = 0;
constexpr size_t WS_COSH = 1 * MiB, WS_SINH = 2 * MiB, WS_COSA = 3 * MiB, WS_SINA = 3 * MiB + 512 * 1024;
constexpr size_t WS_W = 4 * MiB;
constexpr size_t WS_H = 48 * MiB;
constexpr size_t WS_LSE = 120 * MiB;
constexpr size_t WS_BIG = 123 * MiB;
constexpr size_t WS_MIXED = 315 * MiB;
constexpr size_t WS_VT = 379 * MiB;
constexpr size_t WS_END = 491 * MiB;
constexpr size_t W_GU1 = 0, W_DN1 = W_GU1 + (size_t)2 * FF * D, W_GU2 = W_DN1 + (size_t)D * FF, W_DN2 = W_GU2 + (size_t)2 * FF * D,
                 W_IN = W_DN2 + (size_t)D * FF, W_OUT = W_IN + (size_t)NQKV * D, W_MQ = W_OUT + (size_t)D * D, W_MKV = W_MQ + (size_t)256 * D,
                 W_MO = W_MKV + (size_t)512 * D, W_ENDE = W_MO + (size_t)D * 256;
static_assert(W_ENDE * 2 <= 44 * MiB, "weights fit");
constexpr size_t BIG_MEMN = 0, BIG_KVM = 8 * MiB, BIG_VTM = 12 * MiB, BIG_QM = 16 * MiB, BIG_OM = 32 * MiB;

DI unsigned pk2(float a, float b) { f32x2 v = {a, b}; bf2_t r = __builtin_convertvector(v, bf2_t); return __builtin_bit_cast(unsigned, r); }
DI float bf2f(short s) { return __uint_as_float(((unsigned)(unsigned short)s) << 16); }
DI float bfu2f(bf16_t s) { return __uint_as_float(((unsigned)s) << 16); }
DI bf16_t f2bf(float f) { return (bf16_t)(pk2(f, 0.f) & 0xffffu); }
DI float wave_sum(float v) {
#pragma unroll
    for (int o = 1; o < 64; o <<= 1) v += __shfl_xor(v, o);
    return v;
}

namespace pg8 {
constexpr int BM = 256, BK = 64, HALF = 128, HTB = HALF * BK * 2, STAGE_BYTES = 8 * HTB, NXCD = 8, WGM = 8;
DI int lds_byte(int r, int c) { const int st = (r >> 4) * 2 + (c >> 5), rr = r & 15, cc = c & 31, ob = rr * 64 + cc * 2; return st * 1024 + (ob ^ (((ob >> 9) & 1) << 5)); }
DI void stage_rc(int b, int& R, int& C) { const int st = b / 1024, sb = b % 1024, swz = sb ^ (((sb >> 9) & 1) << 5); R = (st >> 1) * 16 + swz / 64; C = (st & 1) * 32 + (swz % 64) / 2; }
DI int perm32(int rho) { const int n = rho >> 4, i = rho & 15; return 8 * (i >> 2) + 4 * n + (i & 3); }
struct Unit { int pm, pn; };
struct Gemm { const bf16_t* A; const bf16_t* Bt; int M, N, K; };
struct StaticOrder {
    int nM, nN, nwg, G, c;
    DI void init(int M, int N, int G_, int c_) { nM = M / BM; nN = N / BM; nwg = nM * nN; G = G_; c = c_; }
    DI bool next(int i, Unit& u) const {
        const long L = (long)i * G + c; if (L >= nwg) return false;
        int wgid = (int)L; { const int q = nwg / NXCD, r = nwg % NXCD, xcd = wgid % NXCD, off = wgid / NXCD; wgid = (xcd < r ? xcd * (q + 1) : r * (q + 1) + (xcd - r) * q) + off; }
        const int nig = WGM * nN, gid = wgid / nig, fm = gid * WGM, gsz = (nM - fm) < WGM ? (nM - fm) : WGM;
        u.pm = fm + ((wgid % nig) % gsz); u.pn = (wgid % nig) / gsz; return true;
    }
};
DI unsigned cvt_pk_bf16(float lo, float hi) { unsigned r; asm volatile("v_cvt_pk_bf16_f32 %0, %1, %2" : "=v"(r) : "v"(lo), "v"(hi)); return r; }

struct EpiStore {
    static constexpr bool PERM = true;
    bf16_t* O; int ldc;
    DI void operator()(const f32x4 (&acc)[2][2][4][2], const Unit& u, int wr, int wc, int fr, int fq) const {
        const int row0 = u.pm * BM + wr * 64 + fr, col0 = u.pn * BM + wc * 32 + 8 * fq;
#pragma unroll
        for (int ai = 0; ai < 2; ++ai)
#pragma unroll
            for (int m = 0; m < 4; ++m) { bf16_t* rowp = O + (size_t)(row0 + ai * HALF + m * 16) * ldc + col0;
#pragma unroll
                for (int bj = 0; bj < 2; ++bj) { const f32x4 v0 = acc[ai][bj][m][0], v1 = acc[ai][bj][m][1];
                    u32x4 w; w.x = cvt_pk_bf16(v0[0], v0[1]); w.y = cvt_pk_bf16(v0[2], v0[3]); w.z = cvt_pk_bf16(v1[0], v1[1]); w.w = cvt_pk_bf16(v1[2], v1[3]);
                    *(u32x4*)(rowp + bj * HALF) = w; } }
    }
};
DI float silu_mul(float g, float u) { const float e = __builtin_amdgcn_exp2f(-g * LOG2E); return g * __builtin_amdgcn_rcpf(1.0f + e) * u; }
struct EpiSwiglu {
    static constexpr bool PERM = true;
    bf16_t* O;
    DI void operator()(const f32x4 (&acc)[2][2][4][2], const Unit& u, int wr, int wc, int fr, int fq) const {
        const int row0 = u.pm * BM + wr * 64 + fr, col0 = u.pn * 128 + wc * 16 + 4 * fq;
#pragma unroll
        for (int ai = 0; ai < 2; ++ai)
#pragma unroll
            for (int m = 0; m < 4; ++m) { bf16_t* rowp = O + (size_t)(row0 + ai * HALF + m * 16) * FF + col0;
#pragma unroll
                for (int bj = 0; bj < 2; ++bj) { const f32x4 g = acc[ai][bj][m][0], up = acc[ai][bj][m][1];
                    u32x2 w; w.x = cvt_pk_bf16(silu_mul(g[0], up[0]), silu_mul(g[1], up[1])); w.y = cvt_pk_bf16(silu_mul(g[2], up[2]), silu_mul(g[3], up[3]));
                    *(u32x2*)(rowp + bj * 64) = w; } }
    }
};
struct EpiResid {
    static constexpr bool PERM = true;
    const float* xin; float* xout; float scale;
    DI void operator()(const f32x4 (&acc)[2][2][4][2], const Unit& u, int wr, int wc, int fr, int fq) const {
        const int row0 = u.pm * BM + wr * 64 + fr, col0 = u.pn * BM + wc * 32 + 8 * fq;
#pragma unroll
        for (int ai = 0; ai < 2; ++ai)
#pragma unroll
            for (int m = 0; m < 4; ++m) { const size_t off = (size_t)(row0 + ai * HALF + m * 16) * D + col0;
#pragma unroll
                for (int bj = 0; bj < 2; ++bj)
#pragma unroll
                    for (int n = 0; n < 2; ++n) { const size_t o = off + bj * HALF + 4 * n; const f32x4 xv = *(const f32x4*)(xin + o);
                        *(f32x4*)(xout + o) = xv + acc[ai][bj][m][n] * scale; } }
    }
};

template <class Epi, class Sched>
DI void gemm_phase(LAS unsigned char* lds, const Gemm g, const Sched& S, const Epi& E, const int tid) {
    const int wid = __builtin_amdgcn_readfirstlane(tid >> 6), lane = tid & 63, wr = wid >> 2, wc = wid & 3, fr = lane & 15, fq = lane >> 4;
    const int K = g.K, nt = K / BK;
    unsigned voffA[2], voffB[2];
#pragma unroll
    for (int i = 0; i < 2; ++i) { int R, C; stage_rc(tid * 16 + i * 8192, R, C); const int Rb = Epi::PERM ? ((R & ~31) + perm32(R & 31)) : R;
        voffA[i] = (unsigned)(R * K + C) * 2u; voffB[i] = (unsigned)(Rb * K + C) * 2u; }
    const size_t kstep = (size_t)(BK * 2);
    const size_t hstep = (size_t)HALF * K * 2;
    const size_t tstep = 2 * hstep;
    const unsigned ldsw = (unsigned)wid * 1024u;
    const int aoff = lds_byte(wr * 64 + fr, fq * 8), boff = lds_byte(wc * 32 + fr, fq * 8);
#define PG8_SA(b, h) (((b) * 2 + (h)) * HTB)
#define PG8_SB(b, h) ((4 + (b) * 2 + (h)) * HTB)
#define PG8_STAGE(bufoff, gbase, voff) do { _Pragma("unroll") for (int _i = 0; _i < 2; ++_i) \
        __builtin_amdgcn_global_load_lds((const unsigned*)((const char*)(gbase) + (voff)[_i]), (LAS unsigned*)(lds + (bufoff) + ldsw + _i * 8192), 16, 0, 0); } while (0)
#define PG8_LDA(dst, b, h) do { _Pragma("unroll") for (int m = 0; m < 4; ++m) _Pragma("unroll") for (int k = 0; k < 2; ++k) dst[m][k] = *(const LAS bf16x8*)(lds + PG8_SA(b, h) + aoff + m * 2048 + k * 1024); } while (0)
#define PG8_LDB(dst, b, h) do { _Pragma("unroll") for (int n = 0; n < 2; ++n) _Pragma("unroll") for (int k = 0; k < 2; ++k) dst[n][k] = *(const LAS bf16x8*)(lds + PG8_SB(b, h) + boff + n * 2048 + k * 1024); } while (0)
#define PG8_MMA(ai, bj, At, Bt) do { __builtin_amdgcn_s_setprio(1); _Pragma("unroll") for (int m = 0; m < 4; ++m) _Pragma("unroll") for (int n = 0; n < 2; ++n) _Pragma("unroll") for (int k = 0; k < 2; ++k) \
        acc[ai][bj][m][n] = __builtin_amdgcn_mfma_f32_16x16x32_bf16(Bt[n][k], At[m][k], acc[ai][bj][m][n], 0, 0, 0); __builtin_amdgcn_s_setprio(0); } while (0)
#define PG8_WAIT_V(n) asm volatile("s_waitcnt vmcnt(" #n ")" ::: "memory")
#define PG8_WAIT_L(n) asm volatile("s_waitcnt lgkmcnt(" #n ")" ::: "memory")
#define PG8_BAR __builtin_amdgcn_s_barrier()
#define PG8_SCHED __builtin_amdgcn_sched_barrier(0)
    Unit cur, nxt; int ui = 0;
    if (!S.next(0, cur)) return;
    f32x4 acc[2][2][4][2];
#pragma unroll
    for (int a = 0; a < 2; ++a)
#pragma unroll
        for (int b = 0; b < 2; ++b)
#pragma unroll
            for (int m = 0; m < 4; ++m)
#pragma unroll
                for (int n = 0; n < 2; ++n) acc[a][b][m][n] = (f32x4){0.f, 0.f, 0.f, 0.f};
    bf16x8 At[4][2], B0[2][2], B1[2][2];
    const char* cA = (const char*)g.A + (size_t)cur.pm * tstep; const char* cB = (const char*)g.Bt + (size_t)cur.pn * tstep;
    PG8_STAGE(PG8_SB(0, 0), cB, voffB); PG8_STAGE(PG8_SB(0, 1), cB + hstep, voffB); PG8_STAGE(PG8_SA(0, 0), cA, voffA); PG8_STAGE(PG8_SA(0, 1), cA + hstep, voffA);
    if (wr == 1) PG8_BAR;
    PG8_WAIT_V(2); PG8_BAR;
    PG8_STAGE(PG8_SB(1, 0), cB + kstep, voffB); PG8_STAGE(PG8_SA(1, 0), cA + kstep, voffA); PG8_STAGE(PG8_SB(1, 1), cB + hstep + kstep, voffB);
    PG8_WAIT_V(6); PG8_BAR;
    for (;;) {
        const bool has_next = S.next(ui + 1, nxt);
        const char* nA = has_next ? (const char*)g.A + (size_t)nxt.pm * tstep : cA; const char* nB = has_next ? (const char*)g.Bt + (size_t)nxt.pn * tstep : cB;
        for (int t = 0; t < nt; t += 2) {
            const bool last = (t == nt - 2);
            const char* a1 = cA + (size_t)(t + 1) * kstep;
            const char* a2 = last ? nA : cA + (size_t)(t + 2) * kstep; const char* b2 = last ? nB : cB + (size_t)(t + 2) * kstep;
            const char* a3 = a2 + kstep; const char* b3 = b2 + kstep;
            PG8_LDB(B0, 0, 0); PG8_LDB(B1, 0, 1); PG8_SCHED; PG8_LDA(At, 0, 0); PG8_STAGE(PG8_SA(1, 1), a1 + hstep, voffA);
            PG8_WAIT_V(8); PG8_WAIT_L(0); PG8_BAR; PG8_MMA(0, 0, At, B0); PG8_MMA(0, 1, At, B1); PG8_BAR; PG8_SCHED;
            PG8_LDA(At, 0, 1); PG8_STAGE(PG8_SB(0, 0), b2, voffB); PG8_STAGE(PG8_SB(0, 1), b2 + hstep, voffB); PG8_STAGE(PG8_SA(0, 0), a2, voffA);
            PG8_WAIT_V(8); PG8_WAIT_L(0); PG8_BAR; PG8_MMA(1, 0, At, B0); PG8_MMA(1, 1, At, B1); PG8_BAR; PG8_SCHED;
            PG8_LDB(B0, 1, 0); PG8_LDB(B1, 1, 1); PG8_SCHED; PG8_LDA(At, 1, 0); PG8_STAGE(PG8_SA(0, 1), a2 + hstep, voffA);
            PG8_WAIT_V(8); PG8_WAIT_L(0); PG8_BAR; PG8_MMA(0, 0, At, B0); PG8_MMA(0, 1, At, B1); PG8_BAR; PG8_SCHED;
            PG8_LDA(At, 1, 1); PG8_STAGE(PG8_SB(1, 0), b3, voffB); PG8_STAGE(PG8_SB(1, 1), b3 + hstep, voffB); PG8_STAGE(PG8_SA(1, 0), a3, voffA);
            PG8_WAIT_V(8); PG8_WAIT_L(0); PG8_BAR; PG8_MMA(1, 0, At, B0); PG8_MMA(1, 1, At, B1); PG8_BAR; PG8_SCHED;
        }
        if (wr == 0) PG8_BAR;
        E(acc, cur, wr, wc, fr, fq);
        if (!has_next) break;
#pragma unroll
        for (int a = 0; a < 2; ++a)
#pragma unroll
            for (int b = 0; b < 2; ++b)
#pragma unroll
                for (int m = 0; m < 4; ++m)
#pragma unroll
                    for (int n = 0; n < 2; ++n) acc[a][b][m][n] = (f32x4){0.f, 0.f, 0.f, 0.f};
        cur = nxt; cA = nA; cB = nB; ++ui;
        if (wr == 1) PG8_BAR;
    }
    PG8_WAIT_V(0);
    PG8_BAR;
#undef PG8_SA
#undef PG8_SB
#undef PG8_STAGE
#undef PG8_LDA
#undef PG8_LDB
#undef PG8_MMA
#undef PG8_WAIT_V
#undef PG8_WAIT_L
#undef PG8_BAR
#undef PG8_SCHED
}
}

struct Params { const float* in[25]; float* out; unsigned char* ws; int lo, hi; };

struct Ctx {
    const Params* p; int l; int tid, lane, wave, gw, ngw, G, bid;
    LAS unsigned char* lds;
};

DI void transpose_item(const float* W, int K, int N, bf16_t* WT, int sh, int add, LAS float* scr, int item, int lane) {
    const int nblk = N / 32, kb = item / nblk, nb = item % nblk, k0 = 64 * kb, n0 = 32 * nb;
#pragma unroll 8
    for (int i = 0; i < 32; ++i) { const int kk = 2 * i + (lane >> 5); scr[kk * 33 + (lane & 31)] = W[(size_t)(k0 + kk) * N + n0 + (lane & 31)]; }
    asm volatile("s_waitcnt lgkmcnt(0)" ::: "memory");
    const int c = lane & 7;
#pragma unroll
    for (int j = 0; j < 4; ++j) { const int n = (lane >> 3) + 8 * j; const LAS float* s = scr + (8 * c) * 33 + n;
        u32x4 o; o.x = pk2(s[0 * 33], s[1 * 33]); o.y = pk2(s[2 * 33], s[3 * 33]); o.z = pk2(s[4 * 33], s[5 * 33]); o.w = pk2(s[6 * 33], s[7 * 33]);
        const int nn = n0 + n; const int row = ((nn >> 2) << sh) + (nn & 3) + add;
        *(u32x4*)(WT + (size_t)row * K + k0 + 8 * c) = o; }
    asm volatile("s_waitcnt lgkmcnt(0)" ::: "memory");
}

DI void norm_row_bf16(const float* xrow, const float* g, bf16_t* orow, int lane) {
    const f32x4* xr = (const f32x4*)xrow + lane; const f32x4* gr = (const f32x4*)g + lane;
    f32x4 v[4]; float s = 0.f;
#pragma unroll
    for (int j = 0; j < 4; ++j) { v[j] = xr[64 * j]; s += (v[j].x * v[j].x + v[j].y * v[j].y) + (v[j].z * v[j].z + v[j].w * v[j].w); }
    const float rstd = 1.0f / sqrtf(wave_sum(s) * (1.f / D) + EPS);
    u32x2* o8 = (u32x2*)orow + lane;
#pragma unroll
    for (int j = 0; j < 4; ++j) { const f32x4 gv = gr[64 * j]; u32x2 w; w.x = pk2(v[j].x * rstd * gv.x, v[j].y * rstd * gv.y); w.y = pk2(v[j].z * rstd * gv.z, v[j].w * rstd * gv.w); o8[64 * j] = w; }
}
DI void norm_row_f32(const float* xrow, const float* g, float* orow, int lane) {
    const f32x4* xr = (const f32x4*)xrow + lane; const f32x4* gr = (const f32x4*)g + lane;
    f32x4 v[4]; float s = 0.f;
#pragma unroll
    for (int j = 0; j < 4; ++j) { v[j] = xr[64 * j]; s += (v[j].x * v[j].x + v[j].y * v[j].y) + (v[j].z * v[j].z + v[j].w * v[j].w); }
    const float rstd = 1.0f / sqrtf(wave_sum(s) * (1.f / D) + EPS);
    f32x4* o = (f32x4*)orow + lane;
#pragma unroll
    for (int j = 0; j < 4; ++j) { const f32x4 gv = gr[64 * j]; o[64 * j] = v[j] * rstd * gv; }
}
DI void norm_phase(const Ctx& c, const float* x, const float* g, bf16_t* H, int rows) {
    for (int m = c.gw; m < rows; m += c.ngw) norm_row_bf16(x + (size_t)m * D, g, H + (size_t)m * D, c.lane);
}

DI void vt_item(const bf16_t* src  , int pitch, bf16_t* dst  , int dst_ld, int t0, int d, int L, LAS bf16_t* tile, int lane) {
#pragma unroll 8
    for (int t = 0; t < 64; ++t) tile[lane * 66 + t] = src[(size_t)t * pitch + lane];
    asm volatile("s_waitcnt lgkmcnt(0)" ::: "memory");
    const int pos = t0 + lane; const int idx = (pos % d) * L + pos / d;
#pragma unroll 8
    for (int dd = 0; dd < 64; ++dd) dst[(size_t)dd * dst_ld + idx] = tile[dd * 66 + lane];
    asm volatile("s_waitcnt lgkmcnt(0)" ::: "memory");
}

#define MFMA32(a, b, c) __builtin_amdgcn_mfma_f32_32x32x16_bf16((a), (b), (c), 0, 0, 0)
DI int crow(int i, int h) { return (i & 3) + 8 * (i >> 2) + 4 * h; }
DI f32x16 zero16() { f32x16 z;
#pragma unroll
    for (int i = 0; i < 16; ++i) z[i] = 0.f; return z; }
template <int KS> DI f32x16 qk_block(const bf16_t* krow, const bf16x8 (&qf)[KS]) {
    f32x16 st = zero16();
#pragma unroll
    for (int s = 0; s < KS; ++s) { const bf16x8 kf = *(const bf16x8*)(krow + 16 * s); st = MFMA32(kf, qf[s], st); }
    return st;
}
DI void load_vf(bf16x8 (&vf)[2][2], const bf16_t* vt, int LD) {
#pragma unroll
    for (int db = 0; db < 2; ++db)
#pragma unroll
        for (int s = 0; s < 2; ++s) { const bf16_t* p = vt + (size_t)db * 32 * LD + 16 * s; const s16x4 a = *(const s16x4*)p; const s16x4 b = *(const s16x4*)(p + 8);
            vf[db][s] = __builtin_shufflevector(a, b, 0, 1, 2, 3, 4, 5, 6, 7); }
}
DI void softmax_pv(f32x16 st, float& m, float& l, f32x16& oa, f32x16& ob, float c, int kidx0, int lo, int hi, int h, const bf16x8 (&vf)[2][2]) {
    float mx = m;
#pragma unroll
    for (int i = 0; i < 16; ++i) { const int kid = kidx0 + crow(i, h); float v = st[i] * c; v = (kid >= lo && kid <= hi) ? v : -1e30f; st[i] = v; mx = fmaxf(mx, v); }
    mx = fmaxf(mx, __shfl_xor(mx, 32));
    const float alpha = __builtin_amdgcn_exp2f(m - mx);
    m = mx;
    float rs = 0.f;
#pragma unroll
    for (int i = 0; i < 16; ++i) { const float p = __builtin_amdgcn_exp2f(st[i] - mx); st[i] = p; rs += p; }
    rs += __shfl_xor(rs, 32);
    l = l * alpha + rs;
#pragma unroll
    for (int i = 0; i < 16; ++i) { oa[i] *= alpha; ob[i] *= alpha; }
#pragma unroll
    for (int s = 0; s < 2; ++s) {
        u32x4 pw; pw.x = pk2(st[8 * s], st[8 * s + 1]); pw.y = pk2(st[8 * s + 2], st[8 * s + 3]); pw.z = pk2(st[8 * s + 4], st[8 * s + 5]); pw.w = pk2(st[8 * s + 6], st[8 * s + 7]);
        const bf16x8 pb = __builtin_bit_cast(bf16x8, pw);
        oa = MFMA32(vf[0][s], pb, oa); ob = MFMA32(vf[1][s], pb, ob);
    }
}
DI void store_o(bf16_t* orow, const f32x16& oa, const f32x16& ob, float sc, int h) {
#pragma unroll
    for (int g4 = 0; g4 < 4; ++g4) {
        u32x2 w; w.x = pk2(oa[4 * g4] * sc, oa[4 * g4 + 1] * sc); w.y = pk2(oa[4 * g4 + 2] * sc, oa[4 * g4 + 3] * sc);
        *(u32x2*)(orow + 8 * g4 + 4 * h) = w;
        u32x2 w2; w2.x = pk2(ob[4 * g4] * sc, ob[4 * g4 + 1] * sc); w2.y = pk2(ob[4 * g4 + 2] * sc, ob[4 * g4 + 3] * sc);
        *(u32x2*)(orow + 32 + 8 * g4 + 4 * h) = w2;
    }
}
constexpr int BIGI = 1 << 29;

DI void attn_A_item(const Ctx& c, int b, int hd, int qt, float lam, float lam_init, const float* subln) {
    const int lane = c.lane, r = lane & 31, h = lane >> 5;
    const bf16_t* QKV = (const bf16_t*)(c.p->ws + WS_BIG);
    const size_t tok_q = (size_t)b * SEQ + qt * 32 + r;
    const bf16_t* qrow = QKV + tok_q * NQKV + COL_QA + hd * 64 + 8 * h;
    bf16x8 qf1[2], qf2[2];
#pragma unroll
    for (int s = 0; s < 2; ++s) { qf1[s] = *(const bf16x8*)(qrow + 16 * s); qf2[s] = *(const bf16x8*)(qrow + 32 + 16 * s); }
    const bf16_t* kbase = QKV + ((size_t)b * SEQ + r) * NQKV + COL_KA + hd * 64 + 8 * h;
    const bf16_t* vt = (const bf16_t*)(c.p->ws + WS_VT) + ((size_t)(hd * 16 + b) * 64 + r) * SEQ + 4 * h;
    float m1 = -1e30f, l1 = 0.f, m2 = -1e30f, l2 = 0.f;
    f32x16 o1a = zero16(), o1b = zero16(), o2a = zero16(), o2b = zero16();
    const float sc = 0.17677669529663687f * LOG2E;
    const int qidx = qt * 32 + r;
    for (int kb = 0; kb <= qt; ++kb) {
        const int kidx0 = kb * 32;
        const bf16_t* krow = kbase + (size_t)kidx0 * NQKV;
        bf16x8 vf[2][2]; load_vf(vf, vt + kidx0, SEQ);
        const f32x16 st1 = qk_block<2>(krow, qf1);
        const f32x16 st2 = qk_block<2>(krow + 32, qf2);
        softmax_pv(st1, m1, l1, o1a, o1b, sc, kidx0, -BIGI, qidx, h, vf);
        softmax_pv(st2, m2, l2, o2a, o2b, sc, kidx0, -BIGI, qidx, h, vf);
    }
    const float i1 = 1.0f / l1, i2 = lam / l2;
    float ss = 0.f;
#pragma unroll
    for (int i = 0; i < 16; ++i) { o1a[i] = o1a[i] * i1 - o2a[i] * i2; o1b[i] = o1b[i] * i1 - o2b[i] * i2; ss += o1a[i] * o1a[i] + o1b[i] * o1b[i]; }
    ss += __shfl_xor(ss, 32);
    const float rn = (1.0f / sqrtf(ss * (1.f / 64.f) + EPS)) * (1.0f - lam_init);
#pragma unroll
    for (int i = 0; i < 16; ++i) { const int dm = crow(i, h); o1a[i] *= subln[dm]; o1b[i] *= subln[32 + dm]; }
    bf16_t* orow = (bf16_t*)(c.p->ws + WS_MIXED) + tok_q * D + hd * 64;
    store_o(orow, o1a, o1b, rn, h);
}

DI void attn_B_item(const Ctx& c, int br, int b, int hd, int tile) {
    const int lane = c.lane, r = lane & 31, h = lane >> 5;
    const int dsh = 2 * br, d = 1 << dsh, L = SEQ >> dsh, tpr = L >> 5;
    const int rr = tile / tpr, mt = tile % tpr, m0 = mt * 32, mq = m0 + r;
    const bf16_t* QKV = (const bf16_t*)(c.p->ws + WS_BIG);
    const size_t tok_q = (size_t)b * SEQ + mq * d + rr;
    const bf16_t* qrow = QKV + tok_q * NQKV + COL_QB + hd * 64 + 8 * h;
    bf16x8 qf[4];
#pragma unroll
    for (int s = 0; s < 4; ++s) qf[s] = *(const bf16x8*)(qrow + 16 * s);
    const bf16_t* kbase = QKV + ((size_t)b * SEQ + rr + (size_t)r * d) * NQKV + COL_KB + hd * 64 + 8 * h;
    const bf16_t* vt = (const bf16_t*)(c.p->ws + WS_VT) + ((size_t)((10 + hd * 3 + br) * 16 + b) * 64 + r) * SEQ + rr * L + 4 * h;
    float m = -1e30f, l = 0.f; f32x16 oa = zero16(), ob = zero16();
    const float sc = 0.125f * LOG2E;
    int kstart = m0 - 128; if (kstart < 0) kstart = 0;
    for (int kidx0 = kstart; kidx0 <= m0; kidx0 += 32) {
        const bf16_t* krow = kbase + (size_t)kidx0 * d * NQKV;
        bf16x8 vf[2][2]; load_vf(vf, vt + kidx0, SEQ);
        const f32x16 st = qk_block<4>(krow, qf);
        softmax_pv(st, m, l, oa, ob, sc, kidx0, mq - 128, mq, h, vf);
    }
    bf16_t* orow = (bf16_t*)(c.p->ws + WS_H) + ((size_t)br * MTOK + tok_q) * 384 + hd * 64;
    store_o(orow, oa, ob, 1.0f / l, h);
    if (h == 0) ((float*)(c.p->ws + WS_LSE))[((size_t)br * MTOK + tok_q) * 6 + hd] = m + __builtin_amdgcn_logf(l);
}

DI void attn_C_item(const Ctx& c, int b, int hd, int qt) {
    const int lane = c.lane, r = lane & 31, h = lane >> 5;
    const int qb = qt >> 3;
    const bf16_t* QKV = (const bf16_t*)(c.p->ws + WS_BIG);
    const size_t tok_q = (size_t)b * SEQ + qt * 32 + r;
    const bf16_t* qrow = QKV + tok_q * NQKV + COL_QC + hd * 64 + 8 * h;
    bf16x8 qf[4];
#pragma unroll
    for (int s = 0; s < 4; ++s) qf[s] = *(const bf16x8*)(qrow + 16 * s);
    const float* km = (const float*)(c.p->ws + WS_MISC + 4096) + (size_t)(b * 6 + hd) * 8 * 64 + 8 * h;
    float g[7];
#pragma unroll
    for (int n = 0; n < 7; ++n) {
        float dot = 0.f;
        if (n < qb) {
#pragma unroll
            for (int s = 0; s < 4; ++s)
#pragma unroll
                for (int j = 0; j < 8; ++j) dot += bf2f(qf[s][j]) * km[n * 64 + 16 * s + j];
        }
        dot += __shfl_xor(dot, 32);
        g[n] = (n < qb) ? dot : -__builtin_inff();
    }
    unsigned selmask = 0;
#pragma unroll
    for (int n = 0; n < 7; ++n) {
        int cnt = 0;
#pragma unroll
        for (int n2 = 0; n2 < 7; ++n2) if (n2 != n) cnt += (g[n2] > g[n] || (g[n2] == g[n] && n2 < n)) ? 1 : 0;
        if (n < qb && cnt < 3) selmask |= 1u << n;
    }
    const bf16_t* kbase = QKV + ((size_t)b * SEQ + r) * NQKV + COL_KC + hd * 64 + 8 * h;
    const bf16_t* vt = (const bf16_t*)(c.p->ws + WS_VT) + ((size_t)((4 + hd) * 16 + b) * 64 + r) * SEQ + 4 * h;
    float m = -1e30f, l = 0.f; f32x16 oa = zero16(), ob = zero16();
    const float sc = 0.125f * LOG2E;
    const int qidx = qt * 32 + r;
    for (int kb = qb * 8; kb <= qt; ++kb) {
        const int kidx0 = kb * 32;
        bf16x8 vf[2][2]; load_vf(vf, vt + kidx0, SEQ);
        const f32x16 st = qk_block<4>(kbase + (size_t)kidx0 * NQKV, qf);
        softmax_pv(st, m, l, oa, ob, sc, kidx0, -BIGI, qidx, h, vf);
    }
    for (int n = 0; n < qb; ++n) {
        const int mysel = (selmask >> n) & 1;
        if (__ballot(mysel) == 0ull) continue;
        const int lo = mysel ? -BIGI : BIGI, hi = mysel ? BIGI : -BIGI;
        for (int kb = n * 8; kb < n * 8 + 8; ++kb) {
            const int kidx0 = kb * 32;
            bf16x8 vf[2][2]; load_vf(vf, vt + kidx0, SEQ);
            const f32x16 st = qk_block<4>(kbase + (size_t)kidx0 * NQKV, qf);
            softmax_pv(st, m, l, oa, ob, sc, kidx0, lo, hi, h, vf);
        }
    }
    bf16_t* orow = (bf16_t*)(c.p->ws + WS_MIXED) + tok_q * D + 640 + hd * 64;
    store_o(orow, oa, ob, 1.0f / l, h);
}

DI void attn_M_item(const Ctx& c, int b, int hd, int qt) {
    const int lane = c.lane, r = lane & 31, h = lane >> 5;
    const unsigned char* big = c.p->ws + WS_BIG;
    const size_t tok_q = (size_t)b * SEQ + qt * 32 + r;
    const bf16_t* qrow = (const bf16_t*)(big + BIG_QM) + tok_q * 256 + hd * 64 + 8 * h;
    bf16x8 qf[4];
#pragma unroll
    for (int s = 0; s < 4; ++s) qf[s] = *(const bf16x8*)(qrow + 16 * s);
    const bf16_t* kbase = (const bf16_t*)(big + BIG_KVM) + ((size_t)b * MEMLEN + r) * 512 + hd * 64 + 8 * h;
    const bf16_t* vt = (const bf16_t*)(big + BIG_VTM) + ((size_t)(b * 4 + hd) * 64 + r) * MEMLEN + 4 * h;
    float m = -1e30f, l = 0.f; f32x16 oa = zero16(), ob = zero16();
    const float sc = 0.125f * LOG2E;
    for (int kb = 0; kb < 8; ++kb) {
        const int kidx0 = kb * 32;
        bf16x8 vf[2][2]; load_vf(vf, vt + kidx0, MEMLEN);
        const f32x16 st = qk_block<4>(kbase + (size_t)kidx0 * 512, qf);
        softmax_pv(st, m, l, oa, ob, sc, kidx0, -BIGI, BIGI, h, vf);
    }
    bf16_t* orow = (bf16_t*)(big + BIG_OM) + tok_q * 256 + hd * 64;
    store_o(orow, oa, ob, 1.0f / l, h);
}

constexpr int PH_CONV = 0, PH_GU1 = 1, PH_DN1 = 2, PH_NMIX = 3, PH_WIN = 4, PH_POST = 5, PH_ATT = 6, PH_MERGE = 7, PH_WOUT = 8, PH_NMQ = 9, PH_MQ = 10, PH_MATT = 11,
              PH_MO = 12, PH_NF2 = 13, PH_GU2 = 14, PH_DN2 = 15, PH_PER_LAYER = 16, PH_FINAL = 2 * PH_PER_LAYER, PH_TOTAL = PH_FINAL + 1;

DI float lam_init_of(int l) { return l == 0 ? 0.2f : 0.8f - 0.6f * 0.7408182206817179f; }

DI void phase_conv(const Ctx& c) {
    const Params& P = *c.p; const int l = c.l;
    bf16_t* Wb = (bf16_t*)(P.ws + WS_W);
    LAS float* scr = (LAS float*)(c.lds + c.wave * 8448);
    constexpr int I_G = (D / 64) * (FF / 32), I_D = (FF / 64) * (D / 32), I_IN = (D / 64) * (NQKV / 32), I_OUT = (D / 64) * (D / 32), I_MQ = (D / 64) * (256 / 32),
                  I_MKV = (D / 64) * (512 / 32), I_MO = (256 / 64) * (D / 32);
    constexpr int NITEMS = 4 * I_G + 2 * I_D + I_IN + I_OUT + I_MQ + I_MKV + I_MO;
    for (int it = c.gw; it < NITEMS; it += c.ngw) {
        int r = it;
        if (r < I_G) { transpose_item(P.in[4] + (size_t)l * D * FF, D, FF, Wb + W_GU1, 3, 0, scr, r, c.lane); continue; } r -= I_G;
        if (r < I_G) { transpose_item(P.in[5] + (size_t)l * D * FF, D, FF, Wb + W_GU1, 3, 4, scr, r, c.lane); continue; } r -= I_G;
        if (r < I_D) { transpose_item(P.in[6] + (size_t)l * D * FF, FF, D, Wb + W_DN1, 2, 0, scr, r, c.lane); continue; } r -= I_D;
        if (r < I_G) { transpose_item(P.in[21] + (size_t)l * D * FF, D, FF, Wb + W_GU2, 3, 0, scr, r, c.lane); continue; } r -= I_G;
        if (r < I_G) { transpose_item(P.in[22] + (size_t)l * D * FF, D, FF, Wb + W_GU2, 3, 4, scr, r, c.lane); continue; } r -= I_G;
        if (r < I_D) { transpose_item(P.in[23] + (size_t)l * D * FF, FF, D, Wb + W_DN2, 2, 0, scr, r, c.lane); continue; } r -= I_D;
        if (r < I_IN) { transpose_item(P.in[8] + (size_t)l * D * NQKV, D, NQKV, Wb + W_IN, 2, 0, scr, r, c.lane); continue; } r -= I_IN;
        if (r < I_OUT) { transpose_item(P.in[9] + (size_t)l * D * D, D, D, Wb + W_OUT, 2, 0, scr, r, c.lane); continue; } r -= I_OUT;
        if (r < I_MQ) { transpose_item(P.in[17] + (size_t)l * D * 256, D, 256, Wb + W_MQ, 2, 0, scr, r, c.lane); continue; } r -= I_MQ;
        if (r < I_MKV) { transpose_item(P.in[18] + (size_t)l * D * 512, D, 512, Wb + W_MKV, 2, 0, scr, r, c.lane); continue; } r -= I_MKV;
        transpose_item(P.in[19] + (size_t)l * 256 * D, 256, D, Wb + W_MO, 2, 0, scr, r, c.lane);
    }
    const float* xs = (l == 0) ? P.in[0] : P.out;
    norm_phase(c, xs, P.in[3] + (size_t)l * D, (bf16_t*)(P.ws + WS_H), MTOK);
    if (l == 0) {
        const int* pos = (const int*)P.in[2];
        float* cosH = (float*)(P.ws + WS_COSH); float* sinH = (float*)(P.ws + WS_SINH); float* cosA = (float*)(P.ws + WS_COSA); float* sinA = (float*)(P.ws + WS_SINA);
        const int gt = c.bid * 512 + c.tid, ngt = c.G * 512;
        for (int i = gt; i < MTOK * 8; i += ngt) { const int t = i >> 3, f = i & 7; const float invf = powf(500000.0f, -(float)(2 * f) / 16.0f); const float ang = (float)pos[t] * invf;
            float sn, cs; sincosf(ang, &sn, &cs); cosH[i] = cs; sinH[i] = sn; }
        for (int i = gt; i < MTOK * 4; i += ngt) { const int t = i >> 2, f = i & 3; const float invf = powf(500000.0f, -(float)(2 * f) / 8.0f); const float ang = (float)pos[t] * invf;
            float sn, cs; sincosf(ang, &sn, &cs); cosA[i] = cs; sinA[i] = sn; }
        if (c.bid == 0 && c.wave == 0) {
            unsigned* cnt = (unsigned*)(P.ws + WS_MISC);
            cnt[c.lane] = 0u;
            float* lamp = (float*)(P.ws + WS_MISC + 256);
            for (int ll = 0; ll < 2; ++ll) {
                float a = 0.f, bsum = 0.f;
                if (c.lane < 32) { a = P.in[10][ll * 32 + c.lane] * P.in[11][ll * 32 + c.lane]; bsum = P.in[12][ll * 32 + c.lane] * P.in[13][ll * 32 + c.lane]; }
                a = wave_sum(a); bsum = wave_sum(bsum);
                if (c.lane == 0) lamp[ll] = expf(a) - expf(bsum) + lam_init_of(ll);
            }
        }
    }
}

DI void rot_item(const Ctx& c, int item) {
    const Params& P = *c.p; const int lane = c.lane;
    const int g = item >> 7, tb = item & 127, tok0 = tb * 256;
    int col0; bool typeA = false; int kc_head = -1;
    if (g < 8) { col0 = g * 64; typeA = true; }
    else if (g < 14) col0 = COL_QB + (g - 8) * 64;
    else if (g < 20) col0 = COL_KB + (g - 14) * 64;
    else if (g < 26) col0 = COL_QC + (g - 20) * 64;
    else { col0 = COL_KC + (g - 26) * 64; kc_head = g - 26; }
    bf16_t* base = (bf16_t*)(P.ws + WS_BIG) + (size_t)tok0 * NQKV + col0 + lane;
    const float* cosT = (const float*)(P.ws + (typeA ? WS_COSA : WS_COSH)); const float* sinT = (const float*)(P.ws + (typeA ? WS_SINA : WS_SINH));
    const int nf = typeA ? 4 : 8;
    const int dl = typeA ? (lane & 31) : lane;
    const bool rot = dl < 2 * nf, first = dl < nf;
    const int fi = dl & (nf - 1);
    float sum = 0.f;
#pragma unroll 4
    for (int t = 0; t < 256; ++t) {
        const float own = bfu2f(base[(size_t)t * NQKV]);
        const float par = __shfl_xor(own, nf);
        float v = own;
        if (rot) { const float cs = cosT[(size_t)(tok0 + t) * nf + fi], sn = sinT[(size_t)(tok0 + t) * nf + fi];
            v = first ? (own * cs - par * sn) : (own * cs + par * sn);
            base[(size_t)t * NQKV] = f2bf(v); }
        sum += v;
    }
    if (kc_head >= 0) { const int b = tb >> 3, n = tb & 7; ((float*)(P.ws + WS_MISC + 4096))[((size_t)(b * 6 + kc_head) * 8 + n) * 64 + lane] = sum * (1.0f / 256.0f); }
}

DI void phase_post(const Ctx& c) {
    const Params& P = *c.p;
    constexpr int N_ROT = 32 * 128, N_VT = 28 * 16 * 32;
    LAS bf16_t* tile = (LAS bf16_t*)(c.lds + c.wave * 8448);
    const bf16_t* QKV = (const bf16_t*)(P.ws + WS_BIG);
    for (int it = c.gw; it < N_ROT + N_VT; it += c.ngw) {
        if (it < N_ROT) { rot_item(c, it); continue; }
        const int v = it - N_ROT; const int slot = v / 512, rem = v % 512, b = rem >> 5, t0 = (rem & 31) * 64;
        int col, d = 1;
        if (slot < 4) col = COL_VA + slot * 64; else if (slot < 10) col = COL_VC + (slot - 4) * 64; else { const int hb = (slot - 10) / 3, br = (slot - 10) % 3; col = COL_VB + hb * 64; d = 1 << (2 * br); }
        vt_item(QKV + ((size_t)b * SEQ + t0) * NQKV + col, NQKV, (bf16_t*)(P.ws + WS_VT) + (size_t)(slot * 16 + b) * 64 * SEQ, SEQ, t0, d, SEQ / d, tile, c.lane);
    }
}

DI void phase_att(const Ctx& c) {
    const Params& P = *c.p; const int l = c.l;
    unsigned* cnt = (unsigned*)(P.ws + WS_MISC) + l;
    const float lam = ((const float*)(P.ws + WS_MISC + 256))[l];
    const float lam_init = lam_init_of(l);
    const float* subln = P.in[14] + l * 64;
    constexpr int N1 = 64 * 160, N2 = 3 * 16 * 6 * 64;
    for (;;) {
        int it = 0;
        if (c.lane == 0) it = (int)atomicAdd(cnt, 1u);
        it = __builtin_amdgcn_readfirstlane(it);
        if (it >= N1 + N2) break;
        if (it < N1) {
            const int qt = 63 - it / 160, sub = it % 160;
            if (sub < 64) attn_A_item(c, sub >> 2, sub & 3, qt, lam, lam_init, subln);
            else { const int s2 = sub - 64; attn_C_item(c, s2 / 6, s2 % 6, qt); }
        } else {
            const int v = it - N1; const int tile = v & 63, rest = v >> 6; const int hd = rest % 6, r2 = rest / 6, b = r2 & 15, br = r2 >> 4;
            attn_B_item(c, br, b, hd, tile);
        }
    }
}

DI void phase_merge(const Ctx& c) {
    const Params& P = *c.p; const int l = c.l;
    const bf16_t* part = (const bf16_t*)(P.ws + WS_H); const float* lse = (const float*)(P.ws + WS_LSE); bf16_t* mixed = (bf16_t*)(P.ws + WS_MIXED);
    const int gt = c.bid * 512 + c.tid, ngt = c.G * 512;
    for (int i = gt; i < MTOK * 48; i += ngt) {
        const int tok = i / 48, rem = i % 48, hd = rem >> 3, g8 = rem & 7;
        const float l0 = lse[(size_t)tok * 6 + hd], l1 = lse[((size_t)MTOK + tok) * 6 + hd], l2 = lse[((size_t)2 * MTOK + tok) * 6 + hd];
        const float mx = fmaxf(l0, fmaxf(l1, l2));
        float w0 = __builtin_amdgcn_exp2f(l0 - mx), w1 = __builtin_amdgcn_exp2f(l1 - mx), w2 = __builtin_amdgcn_exp2f(l2 - mx);
        const float inv = 1.0f / (w0 + w1 + w2); w0 *= inv; w1 *= inv; w2 *= inv;
        const bf16x8 p0 = *(const bf16x8*)(part + (size_t)tok * 384 + hd * 64 + g8 * 8);
        const bf16x8 p1 = *(const bf16x8*)(part + ((size_t)MTOK + tok) * 384 + hd * 64 + g8 * 8);
        const bf16x8 p2 = *(const bf16x8*)(part + ((size_t)2 * MTOK + tok) * 384 + hd * 64 + g8 * 8);
        float o[8];
#pragma unroll
        for (int j = 0; j < 8; ++j) o[j] = w0 * bf2f(p0[j]) + w1 * bf2f(p1[j]) + w2 * bf2f(p2[j]);
        u32x4 w; w.x = pk2(o[0], o[1]); w.y = pk2(o[2], o[3]); w.z = pk2(o[4], o[5]); w.w = pk2(o[6], o[7]);
        *(u32x4*)(mixed + (size_t)tok * D + 256 + hd * 64 + g8 * 8) = w;
    }
    norm_phase(c, P.in[1], P.in[16] + (size_t)l * D, (bf16_t*)(P.ws + WS_BIG + BIG_MEMN), MROWS);
}

template <class Epi> DI void run_gemm(const Ctx& c, const bf16_t* A, const bf16_t* Bt, int M, int N, int K, const Epi& E, int off = 0) {
    pg8::Gemm g{A, Bt, M, N, K}; pg8::StaticOrder S; S.init(M, N, c.G, (c.bid + c.G - off) % c.G);
    pg8::gemm_phase<Epi, pg8::StaticOrder>(c.lds, g, S, E, c.tid);
}

__global__ void __launch_bounds__(512, 2) mega(Params P) {
    extern __shared__ __attribute__((aligned(16))) unsigned char lds_raw[];
    cg::grid_group grid = cg::this_grid();
    for (int ph = P.lo; ph < P.hi; ++ph) {
        if (ph != P.lo) grid.sync();
        int tid_l = threadIdx.x; asm volatile("" : "+v"(tid_l));
        unsigned long long wsu = (unsigned long long)P.ws; asm volatile("" : "+s"(wsu));
        unsigned char* ws = (unsigned char*)wsu;
        Ctx c; c.p = &P; c.tid = tid_l; c.lane = c.tid & 63; c.wave = __builtin_amdgcn_readfirstlane(c.tid >> 6);
        c.G = gridDim.x; c.bid = blockIdx.x; c.gw = c.bid * 8 + c.wave; c.ngw = c.G * 8; c.lds = (LAS unsigned char*)lds_raw;
        bf16_t* Wb = (bf16_t*)(ws + WS_W); bf16_t* H = (bf16_t*)(ws + WS_H); bf16_t* ACT = (bf16_t*)(ws + WS_BIG); bf16_t* MIXED = (bf16_t*)(ws + WS_MIXED);
        if (ph == PH_FINAL) {
            for (int m = c.gw; m < MTOK; m += c.ngw) norm_row_f32(P.out + (size_t)m * D, P.in[24], P.out + (size_t)m * D, c.lane);
            continue;
        }
        const int l = ph / PH_PER_LAYER, q = ph % PH_PER_LAYER; c.l = l;
        switch (q) {
        case PH_CONV: phase_conv(c); break;
        case PH_GU1: { pg8::EpiSwiglu E{ACT}; run_gemm(c, H, Wb + W_GU1, MTOK, 2 * FF, D, E); } break;
        case PH_DN1: { pg8::EpiResid E{(l == 0) ? P.in[0] : P.out, P.out, 0.5f}; run_gemm(c, ACT, Wb + W_DN1, MTOK, D, FF, E); } break;
        case PH_NMIX: norm_phase(c, P.out, P.in[7] + (size_t)l * D, H, MTOK); break;
        case PH_WIN: { pg8::EpiStore E{ACT, NQKV}; run_gemm(c, H, Wb + W_IN, MTOK, NQKV, D, E); } break;
        case PH_POST: phase_post(c); break;
        case PH_ATT: phase_att(c); break;
        case PH_MERGE: phase_merge(c); break;
        case PH_WOUT: { pg8::EpiResid E{P.out, P.out, 1.0f}; run_gemm(c, MIXED, Wb + W_OUT, MTOK, D, D, E);
                        pg8::EpiStore E2{(bf16_t*)(ws + WS_BIG + BIG_KVM), 512}; run_gemm(c, (const bf16_t*)(ws + WS_BIG + BIG_MEMN), Wb + W_MKV, MROWS, 512, D, E2); } break;
        case PH_NMQ: {
            norm_phase(c, P.out, P.in[15] + (size_t)l * D, H, MTOK);
            LAS bf16_t* tile = (LAS bf16_t*)(c.lds + c.wave * 8448);
            for (int it = c.gw; it < 256; it += c.ngw) { const int b = it >> 4, hd = (it >> 2) & 3, t0 = (it & 3) * 64;
                vt_item((const bf16_t*)(ws + WS_BIG + BIG_KVM) + ((size_t)b * MEMLEN + t0) * 512 + 256 + hd * 64, 512,
                        (bf16_t*)(ws + WS_BIG + BIG_VTM) + (size_t)(b * 4 + hd) * 64 * MEMLEN, MEMLEN, t0, 1, MEMLEN, tile, c.lane); }
        } break;
        case PH_MQ: { pg8::EpiStore E{(bf16_t*)(ws + WS_BIG + BIG_QM), 256}; run_gemm(c, H, Wb + W_MQ, MTOK, 256, D, E); } break;
        case PH_MATT: for (int it = c.gw; it < 16 * 4 * 64; it += c.ngw) attn_M_item(c, it >> 8, (it >> 6) & 3, it & 63); break;
        case PH_MO: { pg8::EpiResid E{P.out, P.out, 1.0f}; run_gemm(c, (const bf16_t*)(ws + WS_BIG + BIG_OM), Wb + W_MO, MTOK, D, 256, E); } break;
        case PH_NF2: norm_phase(c, P.out, P.in[20] + (size_t)l * D, H, MTOK); break;
        case PH_GU2: { pg8::EpiSwiglu E{ACT}; run_gemm(c, H, Wb + W_GU2, MTOK, 2 * FF, D, E); } break;
        case PH_DN2: { pg8::EpiResid E{P.out, P.out, 0.5f}; run_gemm(c, ACT, Wb + W_DN2, MTOK, D, FF, E); } break;
        default: break;
        }
    }
}

constexpr int LDS_BYTES = 135168;

extern "C" void kernel_launch(void* const* d_in, const int* in_sizes, int n_in, void* d_out, int out_size, void* d_ws, size_t ws_size, hipStream_t stream) {
    static int grid = 0;
    if (grid == 0) {
        if (n_in != 25 || out_size != MTOK * D || ws_size < WS_END) { fprintf(stderr, "kernel_launch: unexpected shapes (n_in %d out %d ws %zu)\n", n_in, out_size, ws_size); grid = -1; return; }
        int dev = 0, cus = 0, per_cu = 0;
        hipGetDevice(&dev);
        hipDeviceGetAttribute(&cus, hipDeviceAttributeMultiprocessorCount, dev);
        if (hipFuncSetAttribute((const void*)mega, hipFuncAttributeMaxDynamicSharedMemorySize, LDS_BYTES) != hipSuccess) { fprintf(stderr, "kernel_launch: hipFuncSetAttribute failed\n"); grid = -1; return; }
        if (hipOccupancyMaxActiveBlocksPerMultiprocessor(&per_cu, (const void*)mega, 512, LDS_BYTES) != hipSuccess || per_cu < 1) { fprintf(stderr, "kernel_launch: occupancy query gave %d\n", per_cu); per_cu = 1; }
        (void)hipGetLastError();
        grid = cus * per_cu;
    }
    if (grid < 0) return;
    Params p{};
    for (int i = 0; i < 25; ++i) p.in[i] = (const float*)d_in[i];
    p.out = (float*)d_out; p.ws = (unsigned char*)d_ws;
#ifdef MK_PER_PHASE
    for (int ph = 0; ph < PH_TOTAL; ++ph) { p.lo = ph; p.hi = ph + 1; hipLaunchKernelGGL(mega, dim3(grid), dim3(512), LDS_BYTES, stream, p); }
#else
    p.lo = 0; p.hi = PH_TOTAL;
    void* args[] = {&p};
    hipError_t e = hipLaunchCooperativeKernel((const void*)mega, dim3(grid), dim3(512), args, LDS_BYTES, stream);
    if (e != hipSuccess) fprintf(stderr, "cooperative launch failed: %s (grid %d)\n", hipGetErrorString(e), grid);
#endif
}
```

```cpp
#include <hip/hip_runtime.h>
#include <hip/hip_cooperative_groups.h>
#include <cstdio>
#include <cstdint>
namespace cg = cooperative_groups;

#define DI __device__ __forceinline__
#define LAS __attribute__((address_space(3)))
typedef unsigned short bf16_t;
typedef short bf16x8 __attribute__((ext_vector_type(8)));
typedef short s16x4 __attribute__((ext_vector_type(4)));
typedef float f32x4 __attribute__((ext_vector_type(4)));
typedef float f32x2 __attribute__((ext_vector_type(2)));
typedef float f32x16 __attribute__((ext_vector_type(16)));
typedef unsigned u32x4 __attribute__((ext_vector_type(4)));
typedef unsigned u32x2 __attribute__((ext_vector_type(2)));
typedef __bf16 bf2_t __attribute__((ext_vector_type(2)));

constexpr int BATCH = 16, SEQ = 2048, D = 1024, MTOK = BATCH * SEQ, FF = 2816, MEMLEN = 256, MROWS = BATCH * MEMLEN, NQKV = 3072;
constexpr int COL_QA = 0, COL_KA = 256, COL_VA = 512, COL_QB = 768, COL_KB = 1152, COL_VB = 1536, COL_QC = 1920, COL_KC = 2304, COL_VC = 2688;
constexpr float EPS = 1e-6f;
constexpr float LOG2E = 1.4426950408889634f;

constexpr size_t MiB = 1u << 20;
constexpr size_t WS_MISC = 0;
constexpr size_t WS_SSQ = 47 * MiB;
constexpr size_t WS_COSH = 1 * MiB, WS_SINH = 2 * MiB, WS_COSA = 3 * MiB, WS_SINA = 3 * MiB + 512 * 1024;
constexpr size_t WS_W = 4 * MiB;
constexpr size_t WS_H = 48 * MiB;
constexpr size_t WS_LSE = 120 * MiB;
constexpr size_t WS_BIG = 123 * MiB;
constexpr size_t WS_MIXED = 315 * MiB;
constexpr size_t WS_VT = 379 * MiB;
constexpr size_t WS_END = 491 * MiB;
constexpr size_t W_GU1 = 0, W_DN1 = W_GU1 + (size_t)2 * FF * D, W_GU2 = W_DN1 + (size_t)D * FF, W_DN2 = W_GU2 + (size_t)2 * FF * D,
                 W_IN = W_DN2 + (size_t)D * FF, W_OUT = W_IN + (size_t)NQKV * D, W_MQ = W_OUT + (size_t)D * D, W_MKV = W_MQ + (size_t)256 * D,
                 W_MO = W_MKV + (size_t)512 * D, W_ENDE = W_MO + (size_t)D * 256;
static_assert(W_ENDE * 2 <= 43 * MiB, "weights fit");
constexpr size_t BIG_MEMN = 0, BIG_KVM = 8 * MiB, BIG_VTM = 12 * MiB, BIG_QM = 16 * MiB, BIG_OM = 32 * MiB;

DI unsigned pk2(float a, float b) { f32x2 v = {a, b}; bf2_t r = __builtin_convertvector(v, bf2_t); return __builtin_bit_cast(unsigned, r); }
DI float bf2f(short s) { return __uint_as_float(((unsigned)(unsigned short)s) << 16); }
DI float bfu2f(bf16_t s) { return __uint_as_float(((unsigned)s) << 16); }
DI bf16_t f2bf(float f) { return (bf16_t)(pk2(f, 0.f) & 0xffffu); }
DI float wave_sum(float v) {
#pragma unroll
    for (int o = 1; o < 64; o <<= 1) v += __shfl_xor(v, o);
    return v;
}

namespace pg8 {
constexpr int BM = 256, BK = 64, HALF = 128, HTB = HALF * BK * 2, STAGE_BYTES = 8 * HTB, NXCD = 8, WGM = 8;
DI int lds_byte(int r, int c) { const int st = (r >> 4) * 2 + (c >> 5), rr = r & 15, cc = c & 31, ob = rr * 64 + cc * 2; return st * 1024 + (ob ^ (((ob >> 9) & 1) << 5)); }
DI void stage_rc(int b, int& R, int& C) { const int st = b / 1024, sb = b % 1024, swz = sb ^ (((sb >> 9) & 1) << 5); R = (st >> 1) * 16 + swz / 64; C = (st & 1) * 32 + (swz % 64) / 2; }
DI int perm32(int rho) { const int n = rho >> 4, i = rho & 15; return 8 * (i >> 2) + 4 * n + (i & 3); }
struct Unit { int pm, pn; };
struct Gemm { const bf16_t* A; const bf16_t* Bt; int M, N, K; };
struct StaticOrder {
    int nM, nN, nwg, G, c;
    DI void init(int M, int N, int G_, int c_) { nM = M / BM; nN = N / BM; nwg = nM * nN; G = G_; c = c_; }
    DI bool next(int i, Unit& u) const {
        const long L = (long)i * G + c; if (L >= nwg) return false;
        int wgid = (int)L; { const int q = nwg / NXCD, r = nwg % NXCD, xcd = wgid % NXCD, off = wgid / NXCD; wgid = (xcd < r ? xcd * (q + 1) : r * (q + 1) + (xcd - r) * q) + off; }
        const int nig = WGM * nN, gid = wgid / nig, fm = gid * WGM, gsz = (nM - fm) < WGM ? (nM - fm) : WGM;
        u.pm = fm + ((wgid % nig) % gsz); u.pn = (wgid % nig) / gsz; return true;
    }
};
DI unsigned cvt_pk_bf16(float lo, float hi) { unsigned r; asm volatile("v_cvt_pk_bf16_f32 %0, %1, %2" : "=v"(r) : "v"(lo), "v"(hi)); return r; }

DI float rstd_of(const float* ssq, int row) { return ssq ? 1.0f / sqrtf(ssq[row] * (1.f / D) + EPS) : 1.0f; }
struct EpiStore {
    static constexpr bool PERM = true;
    bf16_t* O; int ldc; const float* ssq;
    DI void operator()(const f32x4 (&acc)[2][2][4][2], const Unit& u, int wr, int wc, int fr, int fq) const {
        const int row0 = u.pm * BM + wr * 64 + fr, col0 = u.pn * BM + wc * 32 + 8 * fq;
#pragma unroll
        for (int ai = 0; ai < 2; ++ai)
#pragma unroll
            for (int m = 0; m < 4; ++m) { bf16_t* rowp = O + (size_t)(row0 + ai * HALF + m * 16) * ldc + col0; const float rs = rstd_of(ssq, row0 + ai * HALF + m * 16);
#pragma unroll
                for (int bj = 0; bj < 2; ++bj) { const f32x4 v0 = acc[ai][bj][m][0] * rs, v1 = acc[ai][bj][m][1] * rs;
                    u32x4 w; w.x = cvt_pk_bf16(v0[0], v0[1]); w.y = cvt_pk_bf16(v0[2], v0[3]); w.z = cvt_pk_bf16(v1[0], v1[1]); w.w = cvt_pk_bf16(v1[2], v1[3]);
                    *(u32x4*)(rowp + bj * HALF) = w; } }
    }
};
DI float silu_mul(float g, float u) { const float e = __builtin_amdgcn_exp2f(-g * LOG2E); return g * __builtin_amdgcn_rcpf(1.0f + e) * u; }
struct EpiSwiglu {
    static constexpr bool PERM = true;
    bf16_t* O; const float* ssq;
    DI void operator()(const f32x4 (&acc)[2][2][4][2], const Unit& u, int wr, int wc, int fr, int fq) const {
        const int row0 = u.pm * BM + wr * 64 + fr, col0 = u.pn * 128 + wc * 16 + 4 * fq;
#pragma unroll
        for (int ai = 0; ai < 2; ++ai)
#pragma unroll
            for (int m = 0; m < 4; ++m) { bf16_t* rowp = O + (size_t)(row0 + ai * HALF + m * 16) * FF + col0; const float rs = rstd_of(ssq, row0 + ai * HALF + m * 16);
#pragma unroll
                for (int bj = 0; bj < 2; ++bj) { const f32x4 g = acc[ai][bj][m][0] * rs, up = acc[ai][bj][m][1] * rs;
                    u32x2 w; w.x = cvt_pk_bf16(silu_mul(g[0], up[0]), silu_mul(g[1], up[1])); w.y = cvt_pk_bf16(silu_mul(g[2], up[2]), silu_mul(g[3], up[3]));
                    *(u32x2*)(rowp + bj * 64) = w; } }
    }
};
struct EpiResid {
    static constexpr bool PERM = true;
    const float* xin; float* xout; float scale; bf16_t* xb; float* ssq;
    DI void operator()(const f32x4 (&acc)[2][2][4][2], const Unit& u, int wr, int wc, int fr, int fq) const {
        const int row0 = u.pm * BM + wr * 64 + fr, col0 = u.pn * BM + wc * 32 + 8 * fq;
#pragma unroll
        for (int ai = 0; ai < 2; ++ai)
#pragma unroll
            for (int m = 0; m < 4; ++m) { const int row = row0 + ai * HALF + m * 16; const size_t off = (size_t)row * D + col0; float sq = 0.f;
#pragma unroll
                for (int bj = 0; bj < 2; ++bj) { const size_t o = off + bj * HALF;
                    const f32x4 x0 = *(const f32x4*)(xin + o) + acc[ai][bj][m][0] * scale, x1 = *(const f32x4*)(xin + o + 4) + acc[ai][bj][m][1] * scale;
                    *(f32x4*)(xout + o) = x0; *(f32x4*)(xout + o + 4) = x1;
                    sq += (x0[0] * x0[0] + x0[1] * x0[1]) + (x0[2] * x0[2] + x0[3] * x0[3]) + (x1[0] * x1[0] + x1[1] * x1[1]) + (x1[2] * x1[2] + x1[3] * x1[3]);
                    if (xb) { u32x4 w; w.x = pk2(x0[0], x0[1]); w.y = pk2(x0[2], x0[3]); w.z = pk2(x1[0], x1[1]); w.w = pk2(x1[2], x1[3]); *(u32x4*)(xb + o) = w; } }
                if (ssq) { sq += __shfl_xor(sq, 16); sq += __shfl_xor(sq, 32); if (fq == 0) atomicAdd(ssq + row, sq); } }
    }
};

template <class Epi, class Sched>
DI void gemm_phase(LAS unsigned char* lds, const Gemm g, const Sched& S, const Epi& E, const int tid) {
    const int wid = __builtin_amdgcn_readfirstlane(tid >> 6), lane = tid & 63, wr = wid >> 2, wc = wid & 3, fr = lane & 15, fq = lane >> 4;
    const int K = g.K, nt = K / BK;
    unsigned voffA[2], voffB[2];
#pragma unroll
    for (int i = 0; i < 2; ++i) { int R, C; stage_rc(tid * 16 + i * 8192, R, C); const int Rb = Epi::PERM ? ((R & ~31) + perm32(R & 31)) : R;
        voffA[i] = (unsigned)(R * K + C) * 2u; voffB[i] = (unsigned)(Rb * K + C) * 2u; }
    const size_t kstep = (size_t)(BK * 2);
    const size_t hstep = (size_t)HALF * K * 2;
    const size_t tstep = 2 * hstep;
    const unsigned ldsw = (unsigned)wid * 1024u;
    const int aoff = lds_byte(wr * 64 + fr, fq * 8), boff = lds_byte(wc * 32 + fr, fq * 8);
#define PG8_SA(b, h) (((b) * 2 + (h)) * HTB)
#define PG8_SB(b, h) ((4 + (b) * 2 + (h)) * HTB)
#define PG8_STAGE(bufoff, gbase, voff) do { _Pragma("unroll") for (int _i = 0; _i < 2; ++_i) \
        __builtin_amdgcn_global_load_lds((const unsigned*)((const char*)(gbase) + (voff)[_i]), (LAS unsigned*)(lds + (bufoff) + ldsw + _i * 8192), 16, 0, 0); } while (0)
#define PG8_LDA(dst, b, h) do { _Pragma("unroll") for (int m = 0; m < 4; ++m) _Pragma("unroll") for (int k = 0; k < 2; ++k) dst[m][k] = *(const LAS bf16x8*)(lds + PG8_SA(b, h) + aoff + m * 2048 + k * 1024); } while (0)
#define PG8_LDB(dst, b, h) do { _Pragma("unroll") for (int n = 0; n < 2; ++n) _Pragma("unroll") for (int k = 0; k < 2; ++k) dst[n][k] = *(const LAS bf16x8*)(lds + PG8_SB(b, h) + boff + n * 2048 + k * 1024); } while (0)
#define PG8_MMA(ai, bj, At, Bt) do { __builtin_amdgcn_s_setprio(1); _Pragma("unroll") for (int m = 0; m < 4; ++m) _Pragma("unroll") for (int n = 0; n < 2; ++n) _Pragma("unroll") for (int k = 0; k < 2; ++k) \
        acc[ai][bj][m][n] = __builtin_amdgcn_mfma_f32_16x16x32_bf16(Bt[n][k], At[m][k], acc[ai][bj][m][n], 0, 0, 0); __builtin_amdgcn_s_setprio(0); } while (0)
#define PG8_WAIT_V(n) asm volatile("s_waitcnt vmcnt(" #n ")" ::: "memory")
#define PG8_WAIT_L(n) asm volatile("s_waitcnt lgkmcnt(" #n ")" ::: "memory")
#define PG8_BAR __builtin_amdgcn_s_barrier()
#define PG8_SCHED __builtin_amdgcn_sched_barrier(0)
    Unit cur, nxt; int ui = 0;
    if (!S.next(0, cur)) return;
    f32x4 acc[2][2][4][2];
#pragma unroll
    for (int a = 0; a < 2; ++a)
#pragma unroll
        for (int b = 0; b < 2; ++b)
#pragma unroll
            for (int m = 0; m < 4; ++m)
#pragma unroll
                for (int n = 0; n < 2; ++n) acc[a][b][m][n] = (f32x4){0.f, 0.f, 0.f, 0.f};
    bf16x8 At[4][2], B0[2][2], B1[2][2];
    const char* cA = (const char*)g.A + (size_t)cur.pm * tstep; const char* cB = (const char*)g.Bt + (size_t)cur.pn * tstep;
    PG8_STAGE(PG8_SB(0, 0), cB, voffB); PG8_STAGE(PG8_SB(0, 1), cB + hstep, voffB); PG8_STAGE(PG8_SA(0, 0), cA, voffA); PG8_STAGE(PG8_SA(0, 1), cA + hstep, voffA);
    if (wr == 1) PG8_BAR;
    PG8_WAIT_V(2); PG8_BAR;
    PG8_STAGE(PG8_SB(1, 0), cB + kstep, voffB); PG8_STAGE(PG8_SA(1, 0), cA + kstep, voffA); PG8_STAGE(PG8_SB(1, 1), cB + hstep + kstep, voffB);
    PG8_WAIT_V(6); PG8_BAR;
    for (;;) {
        const bool has_next = S.next(ui + 1, nxt);
        const char* nA = has_next ? (const char*)g.A + (size_t)nxt.pm * tstep : cA; const char* nB = has_next ? (const char*)g.Bt + (size_t)nxt.pn * tstep : cB;
        for (int t = 0; t < nt; t += 2) {
            const bool last = (t == nt - 2);
            const char* a1 = cA + (size_t)(t + 1) * kstep;
            const char* a2 = last ? nA : cA + (size_t)(t + 2) * kstep; const char* b2 = last ? nB : cB + (size_t)(t + 2) * kstep;
            const char* a3 = a2 + kstep; const char* b3 = b2 + kstep;
            PG8_LDB(B0, 0, 0); PG8_LDB(B1, 0, 1); PG8_SCHED; PG8_LDA(At, 0, 0); PG8_STAGE(PG8_SA(1, 1), a1 + hstep, voffA);
            PG8_WAIT_V(8); PG8_WAIT_L(0); PG8_BAR; PG8_MMA(0, 0, At, B0); PG8_MMA(0, 1, At, B1); PG8_BAR; PG8_SCHED;
            PG8_LDA(At, 0, 1); PG8_STAGE(PG8_SB(0, 0), b2, voffB); PG8_STAGE(PG8_SB(0, 1), b2 + hstep, voffB); PG8_STAGE(PG8_SA(0, 0), a2, voffA);
            PG8_WAIT_V(8); PG8_WAIT_L(0); PG8_BAR; PG8_MMA(1, 0, At, B0); PG8_MMA(1, 1, At, B1); PG8_BAR; PG8_SCHED;
            PG8_LDB(B0, 1, 0); PG8_LDB(B1, 1, 1); PG8_SCHED; PG8_LDA(At, 1, 0); PG8_STAGE(PG8_SA(0, 1), a2 + hstep, voffA);
            PG8_WAIT_V(8); PG8_WAIT_L(0); PG8_BAR; PG8_MMA(0, 0, At, B0); PG8_MMA(0, 1, At, B1); PG8_BAR; PG8_SCHED;
            PG8_LDA(At, 1, 1); PG8_STAGE(PG8_SB(1, 0), b3, voffB); PG8_STAGE(PG8_SB(1, 1), b3 + hstep, voffB); PG8_STAGE(PG8_SA(1, 0), a3, voffA);
            PG8_WAIT_V(8); PG8_WAIT_L(0); PG8_BAR; PG8_MMA(1, 0, At, B0); PG8_MMA(1, 1, At, B1); PG8_BAR; PG8_SCHED;
        }
        if (wr == 0) PG8_BAR;
        E(acc, cur, wr, wc, fr, fq);
        if (!has_next) break;
#pragma unroll
        for (int a = 0; a < 2; ++a)
#pragma unroll
            for (int b = 0; b < 2; ++b)
#pragma unroll
                for (int m = 0; m < 4; ++m)
#pragma unroll
                    for (int n = 0; n < 2; ++n) acc[a][b][m][n] = (f32x4){0.f, 0.f, 0.f, 0.f};
        cur = nxt; cA = nA; cB = nB; ++ui;
        if (wr == 1) PG8_BAR;
    }
    PG8_WAIT_V(0);
    PG8_BAR;
#undef PG8_SA
#undef PG8_SB
#undef PG8_STAGE
#undef PG8_LDA
#undef PG8_LDB
#undef PG8_MMA
#undef PG8_WAIT_V
#undef PG8_WAIT_L
#undef PG8_BAR
#undef PG8_SCHED
}
}

struct Params { const float* in[25]; float* out; unsigned char* ws; int lo, hi; };
typedef const __attribute__((address_space(4))) Params CParams;

struct Ctx {
    CParams* p; int l; int tid, lane, wave, gw, ngw, G, bid;
    LAS unsigned char* lds;
};

DI void transpose_item(const float* W, int K, int N, bf16_t* WT, int sh, int add, LAS float* scr, int item, int lane, const float* gain = nullptr) {
    const int nblk = N / 32, kb = item / nblk, nb = item % nblk, k0 = 64 * kb, n0 = 32 * nb;
#pragma unroll 8
    for (int i = 0; i < 32; ++i) { const int kk = 2 * i + (lane >> 5); const float gk = gain ? gain[k0 + kk] : 1.0f; scr[kk * 33 + (lane & 31)] = W[(size_t)(k0 + kk) * N + n0 + (lane & 31)] * gk; }
    asm volatile("s_waitcnt lgkmcnt(0)" ::: "memory");
    const int c = lane & 7;
#pragma unroll
    for (int j = 0; j < 4; ++j) { const int n = (lane >> 3) + 8 * j; const LAS float* s = scr + (8 * c) * 33 + n;
        u32x4 o; o.x = pk2(s[0 * 33], s[1 * 33]); o.y = pk2(s[2 * 33], s[3 * 33]); o.z = pk2(s[4 * 33], s[5 * 33]); o.w = pk2(s[6 * 33], s[7 * 33]);
        const int nn = n0 + n; const int row = ((nn >> 2) << sh) + (nn & 3) + add;
        *(u32x4*)(WT + (size_t)row * K + k0 + 8 * c) = o; }
    asm volatile("s_waitcnt lgkmcnt(0)" ::: "memory");
}

DI void norm_row_bf16(const float* xrow, const float* g, bf16_t* orow, int lane) {
    const f32x4* xr = (const f32x4*)xrow + lane; const f32x4* gr = (const f32x4*)g + lane;
    f32x4 v[4]; float s = 0.f;
#pragma unroll
    for (int j = 0; j < 4; ++j) { v[j] = xr[64 * j]; s += (v[j].x * v[j].x + v[j].y * v[j].y) + (v[j].z * v[j].z + v[j].w * v[j].w); }
    const float rstd = 1.0f / sqrtf(wave_sum(s) * (1.f / D) + EPS);
    u32x2* o8 = (u32x2*)orow + lane;
#pragma unroll
    for (int j = 0; j < 4; ++j) { const f32x4 gv = gr[64 * j]; u32x2 w; w.x = pk2(v[j].x * rstd * gv.x, v[j].y * rstd * gv.y); w.y = pk2(v[j].z * rstd * gv.z, v[j].w * rstd * gv.w); o8[64 * j] = w; }
}
DI void norm_row_f32(const float* xrow, const float* g, float* orow, int lane) {
    const f32x4* xr = (const f32x4*)xrow + lane; const f32x4* gr = (const f32x4*)g + lane;
    f32x4 v[4]; float s = 0.f;
#pragma unroll
    for (int j = 0; j < 4; ++j) { v[j] = xr[64 * j]; s += (v[j].x * v[j].x + v[j].y * v[j].y) + (v[j].z * v[j].z + v[j].w * v[j].w); }
    const float rstd = 1.0f / sqrtf(wave_sum(s) * (1.f / D) + EPS);
    f32x4* o = (f32x4*)orow + lane;
#pragma unroll
    for (int j = 0; j < 4; ++j) { const f32x4 gv = gr[64 * j]; o[64 * j] = v[j] * rstd * gv; }
}
DI void norm_phase(const Ctx& c, const float* x, const float* g, bf16_t* H, int rows) {
    for (int m = c.gw; m < rows; m += c.ngw) norm_row_bf16(x + (size_t)m * D, g, H + (size_t)m * D, c.lane);
}

DI void vt_item(const bf16_t* src  , int pitch, bf16_t* dst  , int dst_ld, int t0, int dsh, int L, LAS bf16_t* tile, int lane) {
    const int c8 = (lane & 7) * 8, tr = lane >> 3, d1 = (1 << dsh) - 1;
    bf16x8 v[8];
#pragma unroll
    for (int i = 0; i < 8; ++i) v[i] = *(const bf16x8*)(src + (size_t)(tr + 8 * i) * pitch + c8);
#pragma unroll
    for (int i = 0; i < 8; ++i) { const int t = tr + 8 * i; const int cp = ((t & d1) << (6 - dsh)) + (t >> dsh);
#pragma unroll
        for (int j = 0; j < 8; ++j) tile[(c8 + j) * 72 + cp] = (bf16_t)v[i][j]; }
    asm volatile("s_waitcnt lgkmcnt(0)" ::: "memory");
    const int seglen = 64 >> dsh;
#pragma unroll
    for (int i = 0; i < 8; ++i) { const int dim = tr + 8 * i; const bf16x8 w = *(const LAS bf16x8*)(tile + dim * 72 + c8);
        bf16_t* drow = dst + (size_t)dim * dst_ld + (t0 >> dsh);
        if (dsh < 4) { const int rr = c8 / seglen, off = c8 % seglen; *(bf16x8*)(drow + (size_t)rr * L + off) = w; }
        else { const int rr = c8 >> 2; *(s16x4*)(drow + (size_t)rr * L) = __builtin_shufflevector(w, w, 0, 1, 2, 3); *(s16x4*)(drow + (size_t)(rr + 1) * L) = __builtin_shufflevector(w, w, 4, 5, 6, 7); } }
    asm volatile("s_waitcnt lgkmcnt(0)" ::: "memory");
}

#define MFMA32(a, b, c) __builtin_amdgcn_mfma_f32_32x32x16_bf16((a), (b), (c), 0, 0, 0)
DI int crow(int i, int h) { return (i & 3) + 8 * (i >> 2) + 4 * h; }
DI f32x16 zero16() { f32x16 z;
#pragma unroll
    for (int i = 0; i < 16; ++i) z[i] = 0.f; return z; }
DI void load_kf(bf16x8 (&kf)[4], const bf16_t* krow) {
#pragma unroll
    for (int s = 0; s < 4; ++s) kf[s] = *(const bf16x8*)(krow + 16 * s);
}
DI f32x16 qk4(const bf16x8 (&kf)[4], const bf16x8 (&qf)[4]) {
    f32x16 st = zero16();
#pragma unroll
    for (int s = 0; s < 4; ++s) st = MFMA32(kf[s], qf[s], st);
    return st;
}
DI f32x16 qk2(const bf16x8& k0, const bf16x8& k1, const bf16x8& q0, const bf16x8& q1) { f32x16 st = zero16(); st = MFMA32(k0, q0, st); st = MFMA32(k1, q1, st); return st; }
DI void load_vf(bf16x8 (&vf)[2][2], const bf16_t* vt, int LD) {
#pragma unroll
    for (int db = 0; db < 2; ++db)
#pragma unroll
        for (int s = 0; s < 2; ++s) { const bf16_t* p = vt + (size_t)db * 32 * LD + 16 * s; const s16x4 a = *(const s16x4*)p; const s16x4 b = *(const s16x4*)(p + 8);
            vf[db][s] = __builtin_shufflevector(a, b, 0, 1, 2, 3, 4, 5, 6, 7); }
}
DI void softmax_pv(f32x16 st, float& m, float& l, f32x16& oa, f32x16& ob, float c, int kidx0, int lo, int hi, int h, const bf16x8 (&vf)[2][2]) {
    float mx = m;
#pragma unroll
    for (int i = 0; i < 16; ++i) { const int kid = kidx0 + crow(i, h); float v = st[i] * c; v = (kid >= lo && kid <= hi) ? v : -1e30f; st[i] = v; mx = fmaxf(mx, v); }
    mx = fmaxf(mx, __shfl_xor(mx, 32));
    const float alpha = __builtin_amdgcn_exp2f(m - mx);
    m = mx;
    float rs = 0.f;
#pragma unroll
    for (int i = 0; i < 16; ++i) { const float p = __builtin_amdgcn_exp2f(st[i] - mx); st[i] = p; rs += p; }
    rs += __shfl_xor(rs, 32);
    l = l * alpha + rs;
#pragma unroll
    for (int i = 0; i < 16; ++i) { oa[i] *= alpha; ob[i] *= alpha; }
#pragma unroll
    for (int s = 0; s < 2; ++s) {
        u32x4 pw; pw.x = pk2(st[8 * s], st[8 * s + 1]); pw.y = pk2(st[8 * s + 2], st[8 * s + 3]); pw.z = pk2(st[8 * s + 4], st[8 * s + 5]); pw.w = pk2(st[8 * s + 6], st[8 * s + 7]);
        const bf16x8 pb = __builtin_bit_cast(bf16x8, pw);
        oa = MFMA32(vf[0][s], pb, oa); ob = MFMA32(vf[1][s], pb, ob);
    }
}
DI void store_o(bf16_t* orow, const f32x16& oa, const f32x16& ob, float sc, int h) {
#pragma unroll
    for (int g4 = 0; g4 < 4; ++g4) {
        u32x2 w; w.x = pk2(oa[4 * g4] * sc, oa[4 * g4 + 1] * sc); w.y = pk2(oa[4 * g4 + 2] * sc, oa[4 * g4 + 3] * sc);
        *(u32x2*)(orow + 8 * g4 + 4 * h) = w;
        u32x2 w2; w2.x = pk2(ob[4 * g4] * sc, ob[4 * g4 + 1] * sc); w2.y = pk2(ob[4 * g4 + 2] * sc, ob[4 * g4 + 3] * sc);
        *(u32x2*)(orow + 32 + 8 * g4 + 4 * h) = w2;
    }
}
constexpr int BIGI = 1 << 29;

DI void attn_A_item(const Ctx& c, int b, int hd, int qt, float lam, float lam_init, const float* subln) {
    const int lane = c.lane, r = lane & 31, h = lane >> 5;
    const bf16_t* QKV = (const bf16_t*)(c.p->ws + WS_BIG);
    const size_t tok_q = (size_t)b * SEQ + qt * 32 + r;
    const bf16_t* qrow = QKV + tok_q * NQKV + COL_QA + hd * 64 + 8 * h;
    bf16x8 qf[4];
#pragma unroll
    for (int s = 0; s < 4; ++s) qf[s] = *(const bf16x8*)(qrow + 16 * s);
    const bf16_t* kbase = QKV + ((size_t)b * SEQ + r) * NQKV + COL_KA + hd * 64 + 8 * h;
    const bf16_t* vt = (const bf16_t*)(c.p->ws + WS_VT) + ((size_t)(hd * 16 + b) * 64 + r) * SEQ + 4 * h;
    float m1 = -1e30f, l1 = 0.f, m2 = -1e30f, l2 = 0.f;
    f32x16 o1a = zero16(), o1b = zero16(), o2a = zero16(), o2b = zero16();
    const float sc = 0.17677669529663687f * LOG2E;
    const int qidx = qt * 32 + r;
    bf16x8 kf[4]; load_kf(kf, kbase);
    for (int kb = 0; kb <= qt; ++kb) {
        const int kidx0 = kb * 32;
        bf16x8 vf[2][2]; load_vf(vf, vt + kidx0, SEQ);
        bf16x8 kn[4]; load_kf(kn, kbase + (size_t)(kb < qt ? kidx0 + 32 : kidx0) * NQKV);
        const f32x16 st1 = qk2(kf[0], kf[1], qf[0], qf[1]);
        const f32x16 st2 = qk2(kf[2], kf[3], qf[2], qf[3]);
        softmax_pv(st1, m1, l1, o1a, o1b, sc, kidx0, -BIGI, qidx, h, vf);
        softmax_pv(st2, m2, l2, o2a, o2b, sc, kidx0, -BIGI, qidx, h, vf);
#pragma unroll
        for (int s = 0; s < 4; ++s) kf[s] = kn[s];
    }
    const float i1 = 1.0f / l1, i2 = lam / l2;
    float ss = 0.f;
#pragma unroll
    for (int i = 0; i < 16; ++i) { o1a[i] = o1a[i] * i1 - o2a[i] * i2; o1b[i] = o1b[i] * i1 - o2b[i] * i2; ss += o1a[i] * o1a[i] + o1b[i] * o1b[i]; }
    ss += __shfl_xor(ss, 32);
    const float rn = (1.0f / sqrtf(ss * (1.f / 64.f) + EPS)) * (1.0f - lam_init);
#pragma unroll
    for (int i = 0; i < 16; ++i) { const int dm = crow(i, h); o1a[i] *= subln[dm]; o1b[i] *= subln[32 + dm]; }
    bf16_t* orow = (bf16_t*)(c.p->ws + WS_MIXED) + tok_q * D + hd * 64;
    store_o(orow, o1a, o1b, rn, h);
}

DI void attn_B_item(const Ctx& c, int br, int b, int hd, int tile) {
    const int lane = c.lane, r = lane & 31, h = lane >> 5;
    const int dsh = 2 * br, d = 1 << dsh, L = SEQ >> dsh, tpr = L >> 5;
    const int rr = tile / tpr, mt = tile % tpr, m0 = mt * 32, mq = m0 + r;
    const bf16_t* QKV = (const bf16_t*)(c.p->ws + WS_BIG);
    const size_t tok_q = (size_t)b * SEQ + mq * d + rr;
    const bf16_t* qrow = QKV + tok_q * NQKV + COL_QB + hd * 64 + 8 * h;
    bf16x8 qf[4];
#pragma unroll
    for (int s = 0; s < 4; ++s) qf[s] = *(const bf16x8*)(qrow + 16 * s);
    const bf16_t* kbase = QKV + ((size_t)b * SEQ + rr + (size_t)r * d) * NQKV + COL_KB + hd * 64 + 8 * h;
    const bf16_t* vt = (const bf16_t*)(c.p->ws + WS_VT) + ((size_t)((10 + hd * 3 + br) * 16 + b) * 64 + r) * SEQ + rr * L + 4 * h;
    float m = -1e30f, l = 0.f; f32x16 oa = zero16(), ob = zero16();
    const float sc = 0.125f * LOG2E;
    int kstart = m0 - 128; if (kstart < 0) kstart = 0;
    bf16x8 kf[4]; load_kf(kf, kbase + (size_t)kstart * d * NQKV);
    for (int kidx0 = kstart; kidx0 <= m0; kidx0 += 32) {
        bf16x8 vf[2][2]; load_vf(vf, vt + kidx0, SEQ);
        bf16x8 kn[4]; load_kf(kn, kbase + (size_t)(kidx0 < m0 ? kidx0 + 32 : kidx0) * d * NQKV);
        const f32x16 st = qk4(kf, qf);
        softmax_pv(st, m, l, oa, ob, sc, kidx0, mq - 128, mq, h, vf);
#pragma unroll
        for (int s = 0; s < 4; ++s) kf[s] = kn[s];
    }
    bf16_t* orow = (bf16_t*)(c.p->ws + WS_H) + ((size_t)br * MTOK + tok_q) * 384 + hd * 64;
    store_o(orow, oa, ob, 1.0f / l, h);
    if (h == 0) ((float*)(c.p->ws + WS_LSE))[((size_t)br * MTOK + tok_q) * 6 + hd] = m + __builtin_amdgcn_logf(l);
}

DI void attn_C_item(const Ctx& c, int b, int hd, int qt) {
    const int lane = c.lane, r = lane & 31, h = lane >> 5;
    const int qb = qt >> 3;
    const bf16_t* QKV = (const bf16_t*)(c.p->ws + WS_BIG);
    const size_t tok_q = (size_t)b * SEQ + qt * 32 + r;
    const bf16_t* qrow = QKV + tok_q * NQKV + COL_QC + hd * 64 + 8 * h;
    bf16x8 qf[4];
#pragma unroll
    for (int s = 0; s < 4; ++s) qf[s] = *(const bf16x8*)(qrow + 16 * s);
    const float* km = (const float*)(c.p->ws + WS_MISC + 4096) + (size_t)(b * 6 + hd) * 8 * 64 + 8 * h;
    float g[7];
#pragma unroll
    for (int n = 0; n < 7; ++n) {
        float dot = 0.f;
        if (n < qb) {
#pragma unroll
            for (int s = 0; s < 4; ++s)
#pragma unroll
                for (int j = 0; j < 8; ++j) dot += bf2f(qf[s][j]) * km[n * 64 + 16 * s + j];
        }
        dot += __shfl_xor(dot, 32);
        g[n] = (n < qb) ? dot : -__builtin_inff();
    }
    unsigned selmask = 0;
#pragma unroll
    for (int n = 0; n < 7; ++n) {
        int cnt = 0;
#pragma unroll
        for (int n2 = 0; n2 < 7; ++n2) if (n2 != n) cnt += (g[n2] > g[n] || (g[n2] == g[n] && n2 < n)) ? 1 : 0;
        if (n < qb && cnt < 3) selmask |= 1u << n;
    }
    const bf16_t* kbase = QKV + ((size_t)b * SEQ + r) * NQKV + COL_KC + hd * 64 + 8 * h;
    const bf16_t* vt = (const bf16_t*)(c.p->ws + WS_VT) + ((size_t)((4 + hd) * 16 + b) * 64 + r) * SEQ + 4 * h;
    float m = -1e30f, l = 0.f; f32x16 oa = zero16(), ob = zero16();
    const float sc = 0.125f * LOG2E;
    const int qidx = qt * 32 + r;
    bf16x8 kf[4]; load_kf(kf, kbase + (size_t)(qb * 256) * NQKV);
    for (int kb = qb * 8; kb <= qt; ++kb) {
        const int kidx0 = kb * 32;
        bf16x8 vf[2][2]; load_vf(vf, vt + kidx0, SEQ);
        bf16x8 kn[4]; load_kf(kn, kbase + (size_t)(kb < qt ? kidx0 + 32 : kidx0) * NQKV);
        const f32x16 st = qk4(kf, qf);
        softmax_pv(st, m, l, oa, ob, sc, kidx0, -BIGI, qidx, h, vf);
#pragma unroll
        for (int s = 0; s < 4; ++s) kf[s] = kn[s];
    }
    for (int n = 0; n < qb; ++n) {
        const int mysel = (selmask >> n) & 1;
        if (__ballot(mysel) == 0ull) continue;
        const int lo = mysel ? -BIGI : BIGI, hi = mysel ? BIGI : -BIGI;
        load_kf(kf, kbase + (size_t)(n * 256) * NQKV);
        for (int kb = n * 8; kb < n * 8 + 8; ++kb) {
            const int kidx0 = kb * 32;
            bf16x8 vf[2][2]; load_vf(vf, vt + kidx0, SEQ);
            bf16x8 kn[4]; load_kf(kn, kbase + (size_t)(kb < n * 8 + 7 ? kidx0 + 32 : kidx0) * NQKV);
            const f32x16 st = qk4(kf, qf);
            softmax_pv(st, m, l, oa, ob, sc, kidx0, lo, hi, h, vf);
#pragma unroll
            for (int s = 0; s < 4; ++s) kf[s] = kn[s];
        }
    }
    bf16_t* orow = (bf16_t*)(c.p->ws + WS_MIXED) + tok_q * D + 640 + hd * 64;
    store_o(orow, oa, ob, 1.0f / l, h);
}

DI void attn_M_item(const Ctx& c, int b, int hd, int qt) {
    const int lane = c.lane, r = lane & 31, h = lane >> 5;
    const unsigned char* big = c.p->ws + WS_BIG;
    const size_t tok_q = (size_t)b * SEQ + qt * 32 + r;
    const bf16_t* qrow = (const bf16_t*)(big + BIG_QM) + tok_q * 256 + hd * 64 + 8 * h;
    bf16x8 qf[4];
#pragma unroll
    for (int s = 0; s < 4; ++s) qf[s] = *(const bf16x8*)(qrow + 16 * s);
    const bf16_t* kbase = (const bf16_t*)(big + BIG_KVM) + ((size_t)b * MEMLEN + r) * 512 + hd * 64 + 8 * h;
    const bf16_t* vt = (const bf16_t*)(big + BIG_VTM) + ((size_t)(b * 4 + hd) * 64 + r) * MEMLEN + 4 * h;
    float m = -1e30f, l = 0.f; f32x16 oa = zero16(), ob = zero16();
    const float sc = 0.125f * LOG2E;
    bf16x8 kf[4]; load_kf(kf, kbase);
    for (int kb = 0; kb < 8; ++kb) {
        const int kidx0 = kb * 32;
        bf16x8 vf[2][2]; load_vf(vf, vt + kidx0, MEMLEN);
        bf16x8 kn[4]; load_kf(kn, kbase + (size_t)(kb < 7 ? kidx0 + 32 : kidx0) * 512);
        const f32x16 st = qk4(kf, qf);
        softmax_pv(st, m, l, oa, ob, sc, kidx0, -BIGI, BIGI, h, vf);
#pragma unroll
        for (int s = 0; s < 4; ++s) kf[s] = kn[s];
    }
    bf16_t* orow = (bf16_t*)(big + BIG_OM) + tok_q * 256 + hd * 64;
    store_o(orow, oa, ob, 1.0f / l, h);
}

constexpr int PH_CONV = 0, PH_GU1 = 1, PH_DN1 = 2, PH_WIN = 3, PH_POST = 4, PH_ATT = 5, PH_MERGE = 6, PH_WOUT = 7, PH_MQ = 8, PH_MATT = 9,
              PH_MO = 10, PH_GU2 = 11, PH_DN2 = 12, PH_PER_LAYER = 13, PH_FINAL = 2 * PH_PER_LAYER, PH_TOTAL = PH_FINAL + 1;

DI float lam_init_of(int l) { return l == 0 ? 0.2f : 0.8f - 0.6f * 0.7408182206817179f; }
DI float* ssq_buf(unsigned char* ws, int l, int k) { return (float*)(ws + WS_SSQ) + (size_t)(l * 4 + k) * MTOK; }

DI void phase_conv(const Ctx& c) {
    CParams& P = *c.p; const int l = c.l;
    bf16_t* Wb = (bf16_t*)(P.ws + WS_W);
    LAS float* scr = (LAS float*)(c.lds + c.wave * 8448);
    constexpr int I_G = (D / 64) * (FF / 32), I_D = (FF / 64) * (D / 32), I_IN = (D / 64) * (NQKV / 32), I_OUT = (D / 64) * (D / 32), I_MQ = (D / 64) * (256 / 32),
                  I_MKV = (D / 64) * (512 / 32), I_MO = (256 / 64) * (D / 32);
    constexpr int NITEMS = 4 * I_G + 2 * I_D + I_IN + I_OUT + I_MQ + I_MKV + I_MO;
    const float* g1 = P.in[3] + (size_t)l * D; const float* g2 = P.in[20] + (size_t)l * D; const float* gm = P.in[7] + (size_t)l * D; const float* gq = P.in[15] + (size_t)l * D;
    for (int it = c.gw; it < NITEMS; it += c.ngw) {
        int r = it;
        if (r < I_G) { transpose_item(P.in[4] + (size_t)l * D * FF, D, FF, Wb + W_GU1, 3, 0, scr, r, c.lane, g1); continue; } r -= I_G;
        if (r < I_G) { transpose_item(P.in[5] + (size_t)l * D * FF, D, FF, Wb + W_GU1, 3, 4, scr, r, c.lane, g1); continue; } r -= I_G;
        if (r < I_D) { transpose_item(P.in[6] + (size_t)l * D * FF, FF, D, Wb + W_DN1, 2, 0, scr, r, c.lane); continue; } r -= I_D;
        if (r < I_G) { transpose_item(P.in[21] + (size_t)l * D * FF, D, FF, Wb + W_GU2, 3, 0, scr, r, c.lane, g2); continue; } r -= I_G;
        if (r < I_G) { transpose_item(P.in[22] + (size_t)l * D * FF, D, FF, Wb + W_GU2, 3, 4, scr, r, c.lane, g2); continue; } r -= I_G;
        if (r < I_D) { transpose_item(P.in[23] + (size_t)l * D * FF, FF, D, Wb + W_DN2, 2, 0, scr, r, c.lane); continue; } r -= I_D;
        if (r < I_IN) { transpose_item(P.in[8] + (size_t)l * D * NQKV, D, NQKV, Wb + W_IN, 2, 0, scr, r, c.lane, gm); continue; } r -= I_IN;
        if (r < I_OUT) { transpose_item(P.in[9] + (size_t)l * D * D, D, D, Wb + W_OUT, 2, 0, scr, r, c.lane); continue; } r -= I_OUT;
        if (r < I_MQ) { transpose_item(P.in[17] + (size_t)l * D * 256, D, 256, Wb + W_MQ, 2, 0, scr, r, c.lane, gq); continue; } r -= I_MQ;
        if (r < I_MKV) { transpose_item(P.in[18] + (size_t)l * D * 512, D, 512, Wb + W_MKV, 2, 0, scr, r, c.lane); continue; } r -= I_MKV;
        transpose_item(P.in[19] + (size_t)l * 256 * D, 256, D, Wb + W_MO, 2, 0, scr, r, c.lane);
    }
    if (l == 0) {
        bf16_t* XB = (bf16_t*)(P.ws + WS_H); float* ssq0 = ssq_buf(P.ws, 0, 0);
        for (int m = c.gw; m < MTOK; m += c.ngw) {
            const f32x4* xr = (const f32x4*)(P.in[0] + (size_t)m * D) + c.lane; u32x2* o8 = (u32x2*)(XB + (size_t)m * D) + c.lane; float sq = 0.f;
#pragma unroll
            for (int j = 0; j < 4; ++j) { const f32x4 v = xr[64 * j]; sq += (v.x * v.x + v.y * v.y) + (v.z * v.z + v.w * v.w); u32x2 w; w.x = pk2(v.x, v.y); w.y = pk2(v.z, v.w); o8[64 * j] = w; }
            sq = wave_sum(sq); if (c.lane == 0) ssq0[m] = sq;
        }
        const int gt = c.bid * 512 + c.tid, ngt = c.G * 512;
        for (int i = gt; i < 7 * MTOK; i += ngt) ssq0[MTOK + i] = 0.f;
        const int* pos = (const int*)P.in[2];
        float* cosH = (float*)(P.ws + WS_COSH); float* sinH = (float*)(P.ws + WS_SINH); float* cosA = (float*)(P.ws + WS_COSA); float* sinA = (float*)(P.ws + WS_SINA);
        for (int i = gt; i < MTOK * 8; i += ngt) { const int t = i >> 3, f = i & 7; const float invf = powf(500000.0f, -(float)(2 * f) / 16.0f); const float ang = (float)pos[t] * invf;
            float sn, cs; sincosf(ang, &sn, &cs); cosH[i] = cs; sinH[i] = sn; }
        for (int i = gt; i < MTOK * 4; i += ngt) { const int t = i >> 2, f = i & 3; const float invf = powf(500000.0f, -(float)(2 * f) / 8.0f); const float ang = (float)pos[t] * invf;
            float sn, cs; sincosf(ang, &sn, &cs); cosA[i] = cs; sinA[i] = sn; }
        if (c.bid == 0 && c.wave == 0) {
            unsigned* cnt = (unsigned*)(P.ws + WS_MISC);
            cnt[c.lane] = 0u;
            float* lamp = (float*)(P.ws + WS_MISC + 256);
            for (int ll = 0; ll < 2; ++ll) {
                float a = 0.f, bsum = 0.f;
                if (c.lane < 32) { a = P.in[10][ll * 32 + c.lane] * P.in[11][ll * 32 + c.lane]; bsum = P.in[12][ll * 32 + c.lane] * P.in[13][ll * 32 + c.lane]; }
                a = wave_sum(a); bsum = wave_sum(bsum);
                if (c.lane == 0) lamp[ll] = expf(a) - expf(bsum) + lam_init_of(ll);
            }
        }
    }
}

DI void kmean_item(const Ctx& c, int item) {
    CParams& P = *c.p; const int lane = c.lane;
    const int hd = item >> 7, tb = item & 127, tok0 = tb * 256;
    bf16_t* base = (bf16_t*)(P.ws + WS_BIG) + (size_t)tok0 * NQKV + COL_KC + hd * 64 + lane;
    const float* cosT = (const float*)(P.ws + WS_COSH); const float* sinT = (const float*)(P.ws + WS_SINH);
    const bool rot = lane < 16, first = lane < 8; const int fi = lane & 7;
    float sum = 0.f;
#pragma unroll 8
    for (int t = 0; t < 256; ++t) {
        const float own = bfu2f(base[(size_t)t * NQKV]);
        const float par = __shfl_xor(own, 8);
        float v = own;
        if (rot) { const float cs = cosT[(size_t)(tok0 + t) * 8 + fi], sn = sinT[(size_t)(tok0 + t) * 8 + fi];
            v = first ? (own * cs - par * sn) : (own * cs + par * sn);
            base[(size_t)t * NQKV] = f2bf(v); }
        sum += v;
    }
    const int b = tb >> 3, n = tb & 7; ((float*)(P.ws + WS_MISC + 4096))[((size_t)(b * 6 + hd) * 8 + n) * 64 + lane] = sum * (1.0f / 256.0f);
}

DI void rot_fast(const Ctx& c) {
    CParams& P = *c.p;
    bf16_t* QKV = (bf16_t*)(P.ws + WS_BIG);
    const float* cosH = (const float*)(P.ws + WS_COSH); const float* sinH = (const float*)(P.ws + WS_SINH); const float* cosA = (const float*)(P.ws + WS_COSA); const float* sinA = (const float*)(P.ws + WS_SINA);
    const int gt = c.bid * 512 + c.tid, ngt = c.G * 512;
    for (int i = gt; i < MTOK * 34; i += ngt) {
        const int tok = i / 34, sl = i % 34;
        if (sl < 18) {
            const int col = sl < 6 ? COL_QB + sl * 64 : (sl < 12 ? COL_KB + (sl - 6) * 64 : COL_QC + (sl - 12) * 64);
            bf16_t* p = QKV + (size_t)tok * NQKV + col;
            const bf16x8 a = *(const bf16x8*)p, b = *(const bf16x8*)(p + 8);
            const f32x4* cp = (const f32x4*)(cosH + (size_t)tok * 8); const f32x4* sp = (const f32x4*)(sinH + (size_t)tok * 8);
            const f32x4 c0 = cp[0], c1 = cp[1], s0 = sp[0], s1 = sp[1];
            float o1[8], o2[8];
#pragma unroll
            for (int j = 0; j < 8; ++j) { const float x1 = bf2f(a[j]), x2 = bf2f(b[j]); const float cs = j < 4 ? c0[j & 3] : c1[j & 3], sn = j < 4 ? s0[j & 3] : s1[j & 3];
                o1[j] = x1 * cs - x2 * sn; o2[j] = x2 * cs + x1 * sn; }
            u32x4 w1, w2; w1.x = pk2(o1[0], o1[1]); w1.y = pk2(o1[2], o1[3]); w1.z = pk2(o1[4], o1[5]); w1.w = pk2(o1[6], o1[7]);
            w2.x = pk2(o2[0], o2[1]); w2.y = pk2(o2[2], o2[3]); w2.z = pk2(o2[4], o2[5]); w2.w = pk2(o2[6], o2[7]);
            *(u32x4*)p = w1; *(u32x4*)(p + 8) = w2;
        } else {
            bf16_t* p = QKV + (size_t)tok * NQKV + (sl - 18) * 32;
            const bf16x8 a = *(const bf16x8*)p;
            const f32x4 c0 = *(const f32x4*)(cosA + (size_t)tok * 4), s0 = *(const f32x4*)(sinA + (size_t)tok * 4);
            float o[8];
#pragma unroll
            for (int j = 0; j < 4; ++j) { const float x1 = bf2f(a[j]), x2 = bf2f(a[4 + j]); o[j] = x1 * c0[j] - x2 * s0[j]; o[4 + j] = x2 * c0[j] + x1 * s0[j]; }
            u32x4 w; w.x = pk2(o[0], o[1]); w.y = pk2(o[2], o[3]); w.z = pk2(o[4], o[5]); w.w = pk2(o[6], o[7]);
            *(u32x4*)p = w;
        }
    }
}

DI void phase_post(const Ctx& c) {
    CParams& P = *c.p;
    constexpr int N_KM = 6 * 128, N_VT = 28 * 16 * 32;
    LAS bf16_t* tile = (LAS bf16_t*)(c.lds + c.wave * 9216);
    const bf16_t* QKV = (const bf16_t*)(P.ws + WS_BIG);
    for (int it = c.gw; it < N_KM + N_VT; it += c.ngw) {
        if (it < N_KM) { kmean_item(c, it); continue; }
        const int v = it - N_KM; const int slot = v / 512, rem = v % 512, b = rem >> 5, t0 = (rem & 31) * 64;
        int col, dsh = 0;
        if (slot < 4) col = COL_VA + slot * 64; else if (slot < 10) col = COL_VC + (slot - 4) * 64; else { const int hb = (slot - 10) / 3, br = (slot - 10) % 3; col = COL_VB + hb * 64; dsh = 2 * br; }
        vt_item(QKV + ((size_t)b * SEQ + t0) * NQKV + col, NQKV, (bf16_t*)(P.ws + WS_VT) + (size_t)(slot * 16 + b) * 64 * SEQ, SEQ, t0, dsh, SEQ >> dsh, tile, c.lane);
    }
    rot_fast(c);
}

DI void phase_att(const Ctx& c) {
    CParams& P = *c.p; const int l = c.l;
    unsigned* cnt = (unsigned*)(P.ws + WS_MISC) + l;
    const float lam = ((const float*)(P.ws + WS_MISC + 256))[l];
    const float lam_init = lam_init_of(l);
    const float* subln = P.in[14] + l * 64;
    constexpr int N1 = 64 * 160, N2 = 3 * 16 * 6 * 64;
    for (;;) {
        int it = 0;
        if (c.lane == 0) it = (int)atomicAdd(cnt, 1u);
        it = __builtin_amdgcn_readfirstlane(it);
        if (it >= N1 + N2) break;
        if (it < N1) {
            const int qt = 63 - it / 160, sub = it % 160;
            if (sub < 64) attn_A_item(c, sub >> 2, sub & 3, qt, lam, lam_init, subln);
            else { const int s2 = sub - 64; attn_C_item(c, s2 / 6, s2 % 6, qt); }
        } else {
            const int v = it - N1; const int tile = v & 63, rest = v >> 6; const int hd = rest % 6, r2 = rest / 6, b = r2 & 15, br = r2 >> 4;
            attn_B_item(c, br, b, hd, tile);
        }
    }
}

DI void phase_merge(const Ctx& c) {
    CParams& P = *c.p; const int l = c.l;
    const bf16_t* part = (const bf16_t*)(P.ws + WS_H); const float* lse = (const float*)(P.ws + WS_LSE); bf16_t* mixed = (bf16_t*)(P.ws + WS_MIXED);
    const int gt = c.bid * 512 + c.tid, ngt = c.G * 512;
    for (int i = gt; i < MTOK * 48; i += ngt) {
        const int tok = i / 48, rem = i % 48, hd = rem >> 3, g8 = rem & 7;
        const float l0 = lse[(size_t)tok * 6 + hd], l1 = lse[((size_t)MTOK + tok) * 6 + hd], l2 = lse[((size_t)2 * MTOK + tok) * 6 + hd];
        const float mx = fmaxf(l0, fmaxf(l1, l2));
        float w0 = __builtin_amdgcn_exp2f(l0 - mx), w1 = __builtin_amdgcn_exp2f(l1 - mx), w2 = __builtin_amdgcn_exp2f(l2 - mx);
        const float inv = 1.0f / (w0 + w1 + w2); w0 *= inv; w1 *= inv; w2 *= inv;
        const bf16x8 p0 = *(const bf16x8*)(part + (size_t)tok * 384 + hd * 64 + g8 * 8);
        const bf16x8 p1 = *(const bf16x8*)(part + ((size_t)MTOK + tok) * 384 + hd * 64 + g8 * 8);
        const bf16x8 p2 = *(const bf16x8*)(part + ((size_t)2 * MTOK + tok) * 384 + hd * 64 + g8 * 8);
        float o[8];
#pragma unroll
        for (int j = 0; j < 8; ++j) o[j] = w0 * bf2f(p0[j]) + w1 * bf2f(p1[j]) + w2 * bf2f(p2[j]);
        u32x4 w; w.x = pk2(o[0], o[1]); w.y = pk2(o[2], o[3]); w.z = pk2(o[4], o[5]); w.w = pk2(o[6], o[7]);
        *(u32x4*)(mixed + (size_t)tok * D + 256 + hd * 64 + g8 * 8) = w;
    }
    norm_phase(c, P.in[1], P.in[16] + (size_t)l * D, (bf16_t*)(P.ws + WS_BIG + BIG_MEMN), MROWS);
}

template <class Epi> DI void run_gemm(const Ctx& c, const bf16_t* A, const bf16_t* Bt, int M, int N, int K, const Epi& E, int off = 0) {
    pg8::Gemm g{A, Bt, M, N, K}; pg8::StaticOrder S; S.init(M, N, c.G, (c.bid + c.G - off) % c.G);
    pg8::gemm_phase<Epi, pg8::StaticOrder>(c.lds, g, S, E, c.tid);
}

__global__ void __launch_bounds__(512, 2) mega(Params Parg) {
    extern __shared__ __attribute__((aligned(16))) unsigned char lds_raw[];
    cg::grid_group grid = cg::this_grid();
    const int ph_lo = Parg.lo, ph_hi = Parg.hi;
    for (int ph = ph_lo; ph < ph_hi; ++ph) {
        if (ph != ph_lo) grid.sync();
        int tid_l = threadIdx.x; asm volatile("" : "+v"(tid_l));
        unsigned long long kpu = (unsigned long long)__builtin_amdgcn_kernarg_segment_ptr(); asm volatile("" : "+s"(kpu));
        Ctx c; c.p = (CParams*)kpu; c.tid = tid_l; c.lane = c.tid & 63; c.wave = __builtin_amdgcn_readfirstlane(c.tid >> 6);
        int G_l = gridDim.x, bid_l = blockIdx.x; asm volatile("" : "+s"(G_l), "+s"(bid_l));
        c.G = G_l; c.bid = bid_l; c.gw = c.bid * 8 + c.wave; c.ngw = c.G * 8; c.lds = (LAS unsigned char*)lds_raw;
#define PHASE_BEGIN unsigned long long kpl_ = kpu; asm volatile("" : "+s"(kpl_)); c.p = (CParams*)kpl_; CParams& P = *c.p; unsigned char* ws = P.ws; \
        bf16_t* Wb = (bf16_t*)(ws + WS_W); bf16_t* XB = (bf16_t*)(ws + WS_H); bf16_t* ACT = (bf16_t*)(ws + WS_BIG); bf16_t* MIXED = (bf16_t*)(ws + WS_MIXED); (void)Wb; (void)XB; (void)ACT; (void)MIXED;
        if (ph == PH_FINAL) {
            PHASE_BEGIN
            for (int m = c.gw; m < MTOK; m += c.ngw) norm_row_f32(P.out + (size_t)m * D, P.in[24], P.out + (size_t)m * D, c.lane);
            continue;
        }
        const int l = ph / PH_PER_LAYER, q = ph % PH_PER_LAYER; c.l = l;
        switch (q) {
        case PH_CONV: { PHASE_BEGIN phase_conv(c); } break;
        case PH_GU1: { PHASE_BEGIN pg8::EpiSwiglu E{ACT, ssq_buf(ws, l, 0)}; run_gemm(c, XB, Wb + W_GU1, MTOK, 2 * FF, D, E); } break;
        case PH_DN1: { PHASE_BEGIN pg8::EpiResid E{(l == 0) ? P.in[0] : P.out, P.out, 0.5f, XB, ssq_buf(ws, l, 1)}; run_gemm(c, ACT, Wb + W_DN1, MTOK, D, FF, E); } break;
        case PH_WIN: { PHASE_BEGIN pg8::EpiStore E{ACT, NQKV, ssq_buf(ws, l, 1)}; run_gemm(c, XB, Wb + W_IN, MTOK, NQKV, D, E); } break;
        case PH_POST: { PHASE_BEGIN phase_post(c); } break;
        case PH_ATT: { PHASE_BEGIN phase_att(c); } break;
        case PH_MERGE: { PHASE_BEGIN phase_merge(c); } break;
        case PH_WOUT: { PHASE_BEGIN pg8::EpiResid E{P.out, P.out, 1.0f, XB, ssq_buf(ws, l, 2)}; run_gemm(c, MIXED, Wb + W_OUT, MTOK, D, D, E);
                        pg8::EpiStore E2{(bf16_t*)(ws + WS_BIG + BIG_KVM), 512, nullptr}; run_gemm(c, (const bf16_t*)(ws + WS_BIG + BIG_MEMN), Wb + W_MKV, MROWS, 512, D, E2); } break;
        case PH_MQ: { PHASE_BEGIN
            LAS bf16_t* tile = (LAS bf16_t*)(c.lds + c.wave * 9216);
            for (int it = c.gw; it < 256; it += c.ngw) { const int b = it >> 4, hd = (it >> 2) & 3, t0 = (it & 3) * 64;
                vt_item((const bf16_t*)(ws + WS_BIG + BIG_KVM) + ((size_t)b * MEMLEN + t0) * 512 + 256 + hd * 64, 512,
                        (bf16_t*)(ws + WS_BIG + BIG_VTM) + (size_t)(b * 4 + hd) * 64 * MEMLEN, MEMLEN, t0, 0, MEMLEN, tile, c.lane); }
            __syncthreads();
            pg8::EpiStore E{(bf16_t*)(ws + WS_BIG + BIG_QM), 256, ssq_buf(ws, l, 2)}; run_gemm(c, XB, Wb + W_MQ, MTOK, 256, D, E);
        } break;
        case PH_MATT: { PHASE_BEGIN } for (int it = c.gw; it < 16 * 4 * 64; it += c.ngw) attn_M_item(c, it >> 8, (it >> 6) & 3, it & 63); break;
        case PH_MO: { PHASE_BEGIN pg8::EpiResid E{P.out, P.out, 1.0f, XB, ssq_buf(ws, l, 3)}; run_gemm(c, (const bf16_t*)(ws + WS_BIG + BIG_OM), Wb + W_MO, MTOK, D, 256, E); } break;
        case PH_GU2: { PHASE_BEGIN pg8::EpiSwiglu E{ACT, ssq_buf(ws, l, 3)}; run_gemm(c, XB, Wb + W_GU2, MTOK, 2 * FF, D, E); } break;
        case PH_DN2: { PHASE_BEGIN pg8::EpiResid E{P.out, P.out, 0.5f, (l == 0) ? XB : nullptr, (l == 0) ? ssq_buf(ws, 1, 0) : nullptr}; run_gemm(c, ACT, Wb + W_DN2, MTOK, D, FF, E); } break;
        default: break;
        }
    }
}

constexpr int LDS_BYTES = 135168;

extern "C" void kernel_launch(void* const* d_in, const int* in_sizes, int n_in, void* d_out, int out_size, void* d_ws, size_t ws_size, hipStream_t stream) {
    static int grid = 0;
    if (grid == 0) {
        if (n_in != 25 || out_size != MTOK * D || ws_size < WS_END) { fprintf(stderr, "kernel_launch: unexpected shapes (n_in %d out %d ws %zu)\n", n_in, out_size, ws_size); grid = -1; return; }
        int dev = 0, cus = 0, per_cu = 0;
        hipGetDevice(&dev);
        hipDeviceGetAttribute(&cus, hipDeviceAttributeMultiprocessorCount, dev);
        if (hipFuncSetAttribute((const void*)mega, hipFuncAttributeMaxDynamicSharedMemorySize, LDS_BYTES) != hipSuccess) { fprintf(stderr, "kernel_launch: hipFuncSetAttribute failed\n"); grid = -1; return; }
        if (hipOccupancyMaxActiveBlocksPerMultiprocessor(&per_cu, (const void*)mega, 512, LDS_BYTES) != hipSuccess || per_cu < 1) { fprintf(stderr, "kernel_launch: occupancy query gave %d\n", per_cu); per_cu = 1; }
        (void)hipGetLastError();
        grid = cus * per_cu;
    }
    if (grid < 0) return;
    Params p{};
    for (int i = 0; i < 25; ++i) p.in[i] = (const float*)d_in[i];
    p.out = (float*)d_out; p.ws = (unsigned char*)d_ws;
#ifdef MK_PER_PHASE
    for (int ph = 0; ph < PH_TOTAL; ++ph) { p.lo = ph; p.hi = ph + 1; hipLaunchKernelGGL(mega, dim3(grid), dim3(512), LDS_BYTES, stream, p); }
#else
    p.lo = 0; p.hi = PH_TOTAL;
    void* args[] = {&p};
    hipError_t e = hipLaunchCooperativeKernel((const void*)mega, dim3(grid), dim3(512), args, LDS_BYTES, stream);
    if (e != hipSuccess) fprintf(stderr, "cooperative launch failed: %s (grid %d)\n", hipGetErrorString(e), grid);
#endif
}
```

```cpp
#include <hip/hip_runtime.h>
#include <hip/hip_cooperative_groups.h>
#include <cstdio>
#include <cstdint>
namespace cg = cooperative_groups;

#define DI __device__ __forceinline__
#define LAS __attribute__((address_space(3)))
typedef unsigned short bf16_t;
typedef short bf16x8 __attribute__((ext_vector_type(8)));
typedef short s16x4 __attribute__((ext_vector_type(4)));
typedef float f32x4 __attribute__((ext_vector_type(4)));
typedef float f32x2 __attribute__((ext_vector_type(2)));
typedef float f32x16 __attribute__((ext_vector_type(16)));
typedef unsigned u32x4 __attribute__((ext_vector_type(4)));
typedef unsigned u32x2 __attribute__((ext_vector_type(2)));
typedef __bf16 bf2_t __attribute__((ext_vector_type(2)));

constexpr int BATCH = 16, SEQ = 2048, D = 1024, MTOK = BATCH * SEQ, FF = 2816, MEMLEN = 256, MROWS = BATCH * MEMLEN, NQKV = 3072;
constexpr int COL_QA = 0, COL_KA = 256, COL_VA = 512, COL_QB = 768, COL_KB = 1152, COL_VB = 1536, COL_QC = 1920, COL_KC = 2304, COL_VC = 2688;
constexpr float EPS = 1e-6f;
constexpr float LOG2E = 1.4426950408889634f;

constexpr size_t MiB = 1u << 20;
constexpr size_t WS_MISC = 0;
constexpr size_t WS_BAR = 512 * 1024;
constexpr size_t WS_SSQ = 47 * MiB;
constexpr size_t WS_COSH = 1 * MiB, WS_SINH = 2 * MiB, WS_COSA = 3 * MiB, WS_SINA = 3 * MiB + 512 * 1024;
constexpr size_t WS_W = 4 * MiB;
constexpr size_t WS_H = 48 * MiB;
constexpr size_t WS_LSE = 120 * MiB;
constexpr size_t WS_BIG = 123 * MiB;
constexpr size_t WS_MIXED = 315 * MiB;
constexpr size_t WS_VT = 379 * MiB;
constexpr size_t WS_MEMN = 491 * MiB, WS_KVM = 499 * MiB, WS_VTM = 503 * MiB;
constexpr size_t WS_END = 505 * MiB;
constexpr size_t W_GU1 = 0, W_DN1 = W_GU1 + (size_t)2 * FF * D, W_GU2 = W_DN1 + (size_t)D * FF, W_DN2 = W_GU2 + (size_t)2 * FF * D,
                 W_IN = W_DN2 + (size_t)D * FF, W_OUT = W_IN + (size_t)NQKV * D, W_MQ = W_OUT + (size_t)D * D, W_MKV = W_MQ + (size_t)256 * D,
                 W_MO = W_MKV + (size_t)512 * D, W_ENDE = W_MO + (size_t)D * 256;
static_assert(W_ENDE * 2 <= 43 * MiB, "weights fit");
constexpr size_t BIG_QM = 16 * MiB, BIG_OM = 32 * MiB;

DI unsigned pk2(float a, float b) { f32x2 v = {a, b}; bf2_t r = __builtin_convertvector(v, bf2_t); return __builtin_bit_cast(unsigned, r); }
DI float bf2f(short s) { return __uint_as_float(((unsigned)(unsigned short)s) << 16); }
DI float bfu2f(bf16_t s) { return __uint_as_float(((unsigned)s) << 16); }
DI bf16_t f2bf(float f) { return (bf16_t)(pk2(f, 0.f) & 0xffffu); }
DI float wave_sum(float v) {
#pragma unroll
    for (int o = 1; o < 64; o <<= 1) v += __shfl_xor(v, o);
    return v;
}

namespace pg8 {
constexpr int BM = 256, BK = 64, HALF = 128, HTB = HALF * BK * 2, STAGE_BYTES = 8 * HTB, NXCD = 8, WGM = 8;
DI int lds_byte(int r, int c) { const int st = (r >> 4) * 2 + (c >> 5), rr = r & 15, cc = c & 31, ob = rr * 64 + cc * 2; return st * 1024 + (ob ^ (((ob >> 9) & 1) << 5)); }
DI void stage_rc(int b, int& R, int& C) { const int st = b / 1024, sb = b % 1024, swz = sb ^ (((sb >> 9) & 1) << 5); R = (st >> 1) * 16 + swz / 64; C = (st & 1) * 32 + (swz % 64) / 2; }
DI int perm32(int rho) { const int n = rho >> 4, i = rho & 15; return 8 * (i >> 2) + 4 * n + (i & 3); }
struct Unit { int pm, pn; };
struct Gemm { const bf16_t* A; const bf16_t* Bt; int M, N, K; };
struct StaticOrder {
    int nM, nN, nwg, G, c;
    DI void init(int M, int N, int G_, int c_) { nM = M / BM; nN = N / BM; nwg = nM * nN; G = G_; c = c_; }
    DI bool next(int i, Unit& u) const {
        const long L = (long)i * G + c; if (L >= nwg) return false;
        int wgid = (int)L; { const int q = nwg / NXCD, r = nwg % NXCD, xcd = wgid % NXCD, off = wgid / NXCD; wgid = (xcd < r ? xcd * (q + 1) : r * (q + 1) + (xcd - r) * q) + off; }
        const int nig = WGM * nN, gid = wgid / nig, fm = gid * WGM, gsz = (nM - fm) < WGM ? (nM - fm) : WGM;
        u.pm = fm + ((wgid % nig) % gsz); u.pn = (wgid % nig) / gsz; return true;
    }
};
DI unsigned cvt_pk_bf16(float lo, float hi) { unsigned r; asm volatile("v_cvt_pk_bf16_f32 %0, %1, %2" : "=v"(r) : "v"(lo), "v"(hi)); return r; }

DI float rstd_of(const float* ssq, int row) { return ssq ? 1.0f / sqrtf(ssq[row] * (1.f / D) + EPS) : 1.0f; }
struct EpiStore {
    static constexpr bool PERM = true;
    bf16_t* O; int ldc; const float* ssq;
    DI void operator()(const f32x4 (&acc)[2][2][4][2], const Unit& u, int wr, int wc, int fr, int fq) const {
        const int row0 = u.pm * BM + wr * 64 + fr, col0 = u.pn * BM + wc * 32 + 8 * fq;
        float rsv[2][4];
#pragma unroll
        for (int ai = 0; ai < 2; ++ai)
#pragma unroll
            for (int m = 0; m < 4; ++m) rsv[ai][m] = ssq ? ssq[row0 + ai * HALF + m * 16] : 0.f;
#pragma unroll
        for (int ai = 0; ai < 2; ++ai)
#pragma unroll
            for (int m = 0; m < 4; ++m) { bf16_t* rowp = O + (size_t)(row0 + ai * HALF + m * 16) * ldc + col0; const float rs = ssq ? 1.0f / sqrtf(rsv[ai][m] * (1.f / D) + EPS) : 1.0f;
#pragma unroll
                for (int bj = 0; bj < 2; ++bj) { const f32x4 v0 = acc[ai][bj][m][0] * rs, v1 = acc[ai][bj][m][1] * rs;
                    u32x4 w; w.x = cvt_pk_bf16(v0[0], v0[1]); w.y = cvt_pk_bf16(v0[2], v0[3]); w.z = cvt_pk_bf16(v1[0], v1[1]); w.w = cvt_pk_bf16(v1[2], v1[3]);
                    *(u32x4*)(rowp + bj * HALF) = w; } }
    }
};
struct EpiStoreKV {
    static constexpr bool PERM = true;
    bf16_t* O; bf16_t* VT_;
    DI void operator()(const f32x4 (&acc)[2][2][4][2], const Unit& u, int wr, int wc, int fr, int fq) const {
        const int row0 = u.pm * BM + wr * 64 + fr, col0 = u.pn * BM + wc * 32 + 8 * fq;
#pragma unroll
        for (int ai = 0; ai < 2; ++ai)
#pragma unroll
            for (int m = 0; m < 4; ++m) { const int row = row0 + ai * HALF + m * 16;
#pragma unroll
                for (int bj = 0; bj < 2; ++bj) { const f32x4 v0 = acc[ai][bj][m][0], v1 = acc[ai][bj][m][1]; const int col = col0 + bj * HALF;
                    if (u.pn == 0) { u32x4 w; w.x = cvt_pk_bf16(v0[0], v0[1]); w.y = cvt_pk_bf16(v0[2], v0[3]); w.z = cvt_pk_bf16(v1[0], v1[1]); w.w = cvt_pk_bf16(v1[2], v1[3]);
                        *(u32x4*)(O + (size_t)row * 512 + col) = w; }
                    else { bf16_t* vp = VT_ + ((size_t)(row >> 8) * 256 + (col - 256)) * 256 + (row & 255);
#pragma unroll
                        for (int j = 0; j < 4; ++j) { vp[(size_t)j * 256] = f2bf(v0[j]); vp[(size_t)(4 + j) * 256] = f2bf(v1[j]); } } } }
    }
};
DI float silu_mul(float g, float u) { const float e = __builtin_amdgcn_exp2f(-g * LOG2E); return g * __builtin_amdgcn_rcpf(1.0f + e) * u; }
struct EpiSwiglu {
    static constexpr bool PERM = true;
    bf16_t* O; const float* ssq;
    DI void operator()(const f32x4 (&acc)[2][2][4][2], const Unit& u, int wr, int wc, int fr, int fq) const {
        const int row0 = u.pm * BM + wr * 64 + fr, col0 = u.pn * 128 + wc * 16 + 4 * fq;
        float rsv[2][4];
#pragma unroll
        for (int ai = 0; ai < 2; ++ai)
#pragma unroll
            for (int m = 0; m < 4; ++m) rsv[ai][m] = ssq[row0 + ai * HALF + m * 16];
#pragma unroll
        for (int ai = 0; ai < 2; ++ai)
#pragma unroll
            for (int m = 0; m < 4; ++m) { bf16_t* rowp = O + (size_t)(row0 + ai * HALF + m * 16) * FF + col0; const float rs = 1.0f / sqrtf(rsv[ai][m] * (1.f / D) + EPS);
#pragma unroll
                for (int bj = 0; bj < 2; ++bj) { const f32x4 g = acc[ai][bj][m][0] * rs, up = acc[ai][bj][m][1] * rs;
                    u32x2 w; w.x = cvt_pk_bf16(silu_mul(g[0], up[0]), silu_mul(g[1], up[1])); w.y = cvt_pk_bf16(silu_mul(g[2], up[2]), silu_mul(g[3], up[3]));
                    *(u32x2*)(rowp + bj * 64) = w; } }
    }
};
struct EpiResid {
    static constexpr bool PERM = true;
    const float* xin; float* xout; float scale; bf16_t* xb; float* ssq;
    DI void operator()(const f32x4 (&acc)[2][2][4][2], const Unit& u, int wr, int wc, int fr, int fq) const {
        const int row0 = u.pm * BM + wr * 64 + fr, col0 = u.pn * BM + wc * 32 + 8 * fq;
#pragma unroll
        for (int ai = 0; ai < 2; ++ai) {
            f32x4 xv[4][2][2];
#pragma unroll
            for (int m = 0; m < 4; ++m)
#pragma unroll
                for (int bj = 0; bj < 2; ++bj) { const size_t o = (size_t)(row0 + ai * HALF + m * 16) * D + col0 + bj * HALF; xv[m][bj][0] = *(const f32x4*)(xin + o); xv[m][bj][1] = *(const f32x4*)(xin + o + 4); }
#pragma unroll
            for (int m = 0; m < 4; ++m) { const int row = row0 + ai * HALF + m * 16; const size_t off = (size_t)row * D + col0; float sq = 0.f;
#pragma unroll
                for (int bj = 0; bj < 2; ++bj) { const size_t o = off + bj * HALF;
                    const f32x4 x0 = xv[m][bj][0] + acc[ai][bj][m][0] * scale, x1 = xv[m][bj][1] + acc[ai][bj][m][1] * scale;
                    *(f32x4*)(xout + o) = x0; *(f32x4*)(xout + o + 4) = x1;
                    sq += (x0[0] * x0[0] + x0[1] * x0[1]) + (x0[2] * x0[2] + x0[3] * x0[3]) + (x1[0] * x1[0] + x1[1] * x1[1]) + (x1[2] * x1[2] + x1[3] * x1[3]);
                    if (xb) { u32x4 w; w.x = pk2(x0[0], x0[1]); w.y = pk2(x0[2], x0[3]); w.z = pk2(x1[0], x1[1]); w.w = pk2(x1[2], x1[3]); *(u32x4*)(xb + o) = w; } }
                if (ssq) { sq += __shfl_xor(sq, 16); sq += __shfl_xor(sq, 32); if (fq == 0) atomicAdd(ssq + row, sq); } }
        }
    }
};

template <class Epi, class Sched>
DI void gemm_phase(LAS unsigned char* lds, const Gemm g, const Sched& S, const Epi& E, const int tid) {
    const int wid = __builtin_amdgcn_readfirstlane(tid >> 6), lane = tid & 63, wr = wid >> 2, wc = wid & 3, fr = lane & 15, fq = lane >> 4;
    const int K = g.K, nt = K / BK;
    unsigned voffA[2], voffB[2];
#pragma unroll
    for (int i = 0; i < 2; ++i) { int R, C; stage_rc(tid * 16 + i * 8192, R, C); const int Rb = Epi::PERM ? ((R & ~31) + perm32(R & 31)) : R;
        voffA[i] = (unsigned)(R * K + C) * 2u; voffB[i] = (unsigned)(Rb * K + C) * 2u; }
    const size_t kstep = (size_t)(BK * 2);
    const size_t hstep = (size_t)HALF * K * 2;
    const size_t tstep = 2 * hstep;
    const unsigned ldsw = (unsigned)wid * 1024u;
    const int aoff = lds_byte(wr * 64 + fr, fq * 8), boff = lds_byte(wc * 32 + fr, fq * 8);
#define PG8_SA(b, h) (((b) * 2 + (h)) * HTB)
#define PG8_SB(b, h) ((4 + (b) * 2 + (h)) * HTB)
#define PG8_STAGE(bufoff, gbase, voff) do { _Pragma("unroll") for (int _i = 0; _i < 2; ++_i) \
        __builtin_amdgcn_global_load_lds((const unsigned*)((const char*)(gbase) + (voff)[_i]), (LAS unsigned*)(lds + (bufoff) + ldsw + _i * 8192), 16, 0, 0); } while (0)
#define PG8_LDA(dst, b, h) do { _Pragma("unroll") for (int m = 0; m < 4; ++m) _Pragma("unroll") for (int k = 0; k < 2; ++k) dst[m][k] = *(const LAS bf16x8*)(lds + PG8_SA(b, h) + aoff + m * 2048 + k * 1024); } while (0)
#define PG8_LDB(dst, b, h) do { _Pragma("unroll") for (int n = 0; n < 2; ++n) _Pragma("unroll") for (int k = 0; k < 2; ++k) dst[n][k] = *(const LAS bf16x8*)(lds + PG8_SB(b, h) + boff + n * 2048 + k * 1024); } while (0)
#define PG8_MMA(ai, bj, At, Bt) do { __builtin_amdgcn_s_setprio(1); _Pragma("unroll") for (int m = 0; m < 4; ++m) _Pragma("unroll") for (int n = 0; n < 2; ++n) _Pragma("unroll") for (int k = 0; k < 2; ++k) \
        acc[ai][bj][m][n] = __builtin_amdgcn_mfma_f32_16x16x32_bf16(Bt[n][k], At[m][k], acc[ai][bj][m][n], 0, 0, 0); __builtin_amdgcn_s_setprio(0); } while (0)
#define PG8_WAIT_V(n) asm volatile("s_waitcnt vmcnt(" #n ")" ::: "memory")
#define PG8_WAIT_L(n) asm volatile("s_waitcnt lgkmcnt(" #n ")" ::: "memory")
#define PG8_BAR __builtin_amdgcn_s_barrier()
#define PG8_SCHED __builtin_amdgcn_sched_barrier(0)
    Unit cur, nxt; int ui = 0;
    if (!S.next(0, cur)) return;
    f32x4 acc[2][2][4][2];
#pragma unroll
    for (int a = 0; a < 2; ++a)
#pragma unroll
        for (int b = 0; b < 2; ++b)
#pragma unroll
            for (int m = 0; m < 4; ++m)
#pragma unroll
                for (int n = 0; n < 2; ++n) acc[a][b][m][n] = (f32x4){0.f, 0.f, 0.f, 0.f};
    bf16x8 At[4][2], B0[2][2], B1[2][2];
    const char* cA = (const char*)g.A + (size_t)cur.pm * tstep; const char* cB = (const char*)g.Bt + (size_t)cur.pn * tstep;
    PG8_STAGE(PG8_SB(0, 0), cB, voffB); PG8_STAGE(PG8_SB(0, 1), cB + hstep, voffB); PG8_STAGE(PG8_SA(0, 0), cA, voffA); PG8_STAGE(PG8_SA(0, 1), cA + hstep, voffA);
    if (wr == 1) PG8_BAR;
    PG8_WAIT_V(2); PG8_BAR;
    PG8_STAGE(PG8_SB(1, 0), cB + kstep, voffB); PG8_STAGE(PG8_SA(1, 0), cA + kstep, voffA); PG8_STAGE(PG8_SB(1, 1), cB + hstep + kstep, voffB);
    PG8_WAIT_V(6); PG8_BAR;
    for (;;) {
        const bool has_next = S.next(ui + 1, nxt);
        const char* nA = has_next ? (const char*)g.A + (size_t)nxt.pm * tstep : cA; const char* nB = has_next ? (const char*)g.Bt + (size_t)nxt.pn * tstep : cB;
        for (int t = 0; t < nt; t += 2) {
            const bool last = (t == nt - 2);
            const char* a1 = cA + (size_t)(t + 1) * kstep;
            const char* a2 = last ? nA : cA + (size_t)(t + 2) * kstep; const char* b2 = last ? nB : cB + (size_t)(t + 2) * kstep;
            const char* a3 = a2 + kstep; const char* b3 = b2 + kstep;
            PG8_LDB(B0, 0, 0); PG8_LDB(B1, 0, 1); PG8_SCHED; PG8_LDA(At, 0, 0); PG8_STAGE(PG8_SA(1, 1), a1 + hstep, voffA);
            PG8_WAIT_V(8); PG8_WAIT_L(0); PG8_BAR; PG8_MMA(0, 0, At, B0); PG8_MMA(0, 1, At, B1); PG8_BAR; PG8_SCHED;
            PG8_LDA(At, 0, 1); PG8_STAGE(PG8_SB(0, 0), b2, voffB); PG8_STAGE(PG8_SB(0, 1), b2 + hstep, voffB); PG8_STAGE(PG8_SA(0, 0), a2, voffA);
            PG8_WAIT_V(8); PG8_WAIT_L(0); PG8_BAR; PG8_MMA(1, 0, At, B0); PG8_MMA(1, 1, At, B1); PG8_BAR; PG8_SCHED;
            PG8_LDB(B0, 1, 0); PG8_LDB(B1, 1, 1); PG8_SCHED; PG8_LDA(At, 1, 0); PG8_STAGE(PG8_SA(0, 1), a2 + hstep, voffA);
            PG8_WAIT_V(8); PG8_WAIT_L(0); PG8_BAR; PG8_MMA(0, 0, At, B0); PG8_MMA(0, 1, At, B1); PG8_BAR; PG8_SCHED;
            PG8_LDA(At, 1, 1); PG8_STAGE(PG8_SB(1, 0), b3, voffB); PG8_STAGE(PG8_SB(1, 1), b3 + hstep, voffB); PG8_STAGE(PG8_SA(1, 0), a3, voffA);
            PG8_WAIT_V(8); PG8_WAIT_L(0); PG8_BAR; PG8_MMA(1, 0, At, B0); PG8_MMA(1, 1, At, B1); PG8_BAR; PG8_SCHED;
        }
        if (wr == 0) PG8_BAR;
        E(acc, cur, wr, wc, fr, fq);
        if (!has_next) break;
#pragma unroll
        for (int a = 0; a < 2; ++a)
#pragma unroll
            for (int b = 0; b < 2; ++b)
#pragma unroll
                for (int m = 0; m < 4; ++m)
#pragma unroll
                    for (int n = 0; n < 2; ++n) acc[a][b][m][n] = (f32x4){0.f, 0.f, 0.f, 0.f};
        cur = nxt; cA = nA; cB = nB; ++ui;
        if (wr == 1) PG8_BAR;
    }
    PG8_WAIT_V(0);
    PG8_BAR;
#undef PG8_SA
#undef PG8_SB
#undef PG8_STAGE
#undef PG8_LDA
#undef PG8_LDB
#undef PG8_MMA
#undef PG8_WAIT_V
#undef PG8_WAIT_L
#undef PG8_BAR
#undef PG8_SCHED
}
}

DI void grid_barrier(unsigned* bar, unsigned G, unsigned& gen) {
    __syncthreads();
    if (threadIdx.x == 0) {
        ++gen;
        __builtin_amdgcn_fence(__ATOMIC_RELEASE, "agent");
        const unsigned prev = __hip_atomic_fetch_add(bar, 1u, __ATOMIC_RELAXED, __HIP_MEMORY_SCOPE_AGENT);
        if (prev == G * gen - 1u) __hip_atomic_store(bar + 64, gen, __ATOMIC_RELAXED, __HIP_MEMORY_SCOPE_AGENT);
        else while (__hip_atomic_load(bar + 64, __ATOMIC_RELAXED, __HIP_MEMORY_SCOPE_AGENT) < gen) __builtin_amdgcn_s_sleep(1);
        __builtin_amdgcn_fence(__ATOMIC_ACQUIRE, "agent");
    }
    __syncthreads();
}

struct Params { const float* in[25]; float* out; unsigned char* ws; int lo, hi; };
typedef const __attribute__((address_space(4))) Params CParams;

struct Ctx {
    CParams* p; int l; int tid, lane, wave, gw, ngw, G, bid;
    LAS unsigned char* lds;
};

DI void transpose_item(const float* W, int K, int N, bf16_t* WT, int sh, int add, LAS float* scr, int item, int lane, const float* gain = nullptr) {
    const int nblk = N / 32, kb = item / nblk, nb = item % nblk, k0 = 64 * kb, n0 = 32 * nb;
    f32x4 wv[8];
#pragma unroll
    for (int i = 0; i < 8; ++i) { const int kk = (lane >> 3) + 8 * i; wv[i] = *(const f32x4*)(W + (size_t)(k0 + kk) * N + n0 + 4 * (lane & 7)); }
#pragma unroll
    for (int i = 0; i < 8; ++i) { const int kk = (lane >> 3) + 8 * i; const float gk = gain ? gain[k0 + kk] : 1.0f; LAS float* d = scr + kk * 33 + 4 * (lane & 7);
        d[0] = wv[i].x * gk; d[1] = wv[i].y * gk; d[2] = wv[i].z * gk; d[3] = wv[i].w * gk; }
    asm volatile("s_waitcnt lgkmcnt(0)" ::: "memory");
    const int c = lane & 7;
#pragma unroll
    for (int j = 0; j < 4; ++j) { const int n = (lane >> 3) + 8 * j; const LAS float* s = scr + (8 * c) * 33 + n;
        u32x4 o; o.x = pk2(s[0 * 33], s[1 * 33]); o.y = pk2(s[2 * 33], s[3 * 33]); o.z = pk2(s[4 * 33], s[5 * 33]); o.w = pk2(s[6 * 33], s[7 * 33]);
        const int nn = n0 + n; const int row = ((nn >> 2) << sh) + (nn & 3) + add;
        *(u32x4*)(WT + (size_t)row * K + k0 + 8 * c) = o; }
    asm volatile("s_waitcnt lgkmcnt(0)" ::: "memory");
}

DI void norm_row_bf16(const float* xrow, const float* g, bf16_t* orow, int lane) {
    const f32x4* xr = (const f32x4*)xrow + lane; const f32x4* gr = (const f32x4*)g + lane;
    f32x4 v[4]; float s = 0.f;
#pragma unroll
    for (int j = 0; j < 4; ++j) { v[j] = xr[64 * j]; s += (v[j].x * v[j].x + v[j].y * v[j].y) + (v[j].z * v[j].z + v[j].w * v[j].w); }
    const float rstd = 1.0f / sqrtf(wave_sum(s) * (1.f / D) + EPS);
    u32x2* o8 = (u32x2*)orow + lane;
#pragma unroll
    for (int j = 0; j < 4; ++j) { const f32x4 gv = gr[64 * j]; u32x2 w; w.x = pk2(v[j].x * rstd * gv.x, v[j].y * rstd * gv.y); w.y = pk2(v[j].z * rstd * gv.z, v[j].w * rstd * gv.w); o8[64 * j] = w; }
}
DI void norm_row_f32(const float* xrow, const float* g, float* orow, int lane) {
    const f32x4* xr = (const f32x4*)xrow + lane; const f32x4* gr = (const f32x4*)g + lane;
    f32x4 v[4]; float s = 0.f;
#pragma unroll
    for (int j = 0; j < 4; ++j) { v[j] = xr[64 * j]; s += (v[j].x * v[j].x + v[j].y * v[j].y) + (v[j].z * v[j].z + v[j].w * v[j].w); }
    const float rstd = 1.0f / sqrtf(wave_sum(s) * (1.f / D) + EPS);
    f32x4* o = (f32x4*)orow + lane;
#pragma unroll
    for (int j = 0; j < 4; ++j) { const f32x4 gv = gr[64 * j]; o[64 * j] = v[j] * rstd * gv; }
}
DI void norm_phase(const Ctx& c, const float* x, const float* g, bf16_t* H, int rows) {
    for (int m = c.gw; m < rows; m += c.ngw) norm_row_bf16(x + (size_t)m * D, g, H + (size_t)m * D, c.lane);
}

DI void vt_load(bf16x8 (&v)[8], const bf16_t* src  , int pitch, int lane) {
    const int c8 = (lane & 7) * 8, tr = lane >> 3;
#pragma unroll
    for (int i = 0; i < 8; ++i) v[i] = *(const bf16x8*)(src + (size_t)(tr + 8 * i) * pitch + c8);
}
DI void vt_item(const bf16x8 (&v)[8], bf16_t* dst  , int dst_ld, int t0, int dsh, int L, LAS bf16_t* tile, int lane) {
    const int c8 = (lane & 7) * 8, tr = lane >> 3, d1 = (1 << dsh) - 1;
#pragma unroll
    for (int i = 0; i < 8; ++i) { const int t = tr + 8 * i; const int cp = ((t & d1) << (6 - dsh)) + (t >> dsh);
#pragma unroll
        for (int j = 0; j < 8; ++j) tile[(c8 + j) * 72 + cp] = (bf16_t)v[i][j]; }
    asm volatile("s_waitcnt lgkmcnt(0)" ::: "memory");
    const int seglen = 64 >> dsh;
#pragma unroll
    for (int i = 0; i < 8; ++i) { const int dim = tr + 8 * i; const bf16x8 w = *(const LAS bf16x8*)(tile + dim * 72 + c8);
        bf16_t* drow = dst + (size_t)dim * dst_ld + (t0 >> dsh);
        if (dsh < 4) { const int rr = c8 / seglen, off = c8 % seglen; *(bf16x8*)(drow + (size_t)rr * L + off) = w; }
        else { const int rr = c8 >> 2; *(s16x4*)(drow + (size_t)rr * L) = __builtin_shufflevector(w, w, 0, 1, 2, 3); *(s16x4*)(drow + (size_t)(rr + 1) * L) = __builtin_shufflevector(w, w, 4, 5, 6, 7); } }
    asm volatile("s_waitcnt lgkmcnt(0)" ::: "memory");
}

#define MFMA32(a, b, c) __builtin_amdgcn_mfma_f32_32x32x16_bf16((a), (b), (c), 0, 0, 0)
DI int crow(int i, int h) { return (i & 3) + 8 * (i >> 2) + 4 * h; }
DI f32x16 zero16() { f32x16 z;
#pragma unroll
    for (int i = 0; i < 16; ++i) z[i] = 0.f; return z; }
DI void load_kf(bf16x8 (&kf)[4], const bf16_t* krow) {
#pragma unroll
    for (int s = 0; s < 4; ++s) kf[s] = *(const bf16x8*)(krow + 16 * s);
}
DI f32x16 qk4(const bf16x8 (&kf)[4], const bf16x8 (&qf)[4]) {
    f32x16 st = zero16();
#pragma unroll
    for (int s = 0; s < 4; ++s) st = MFMA32(kf[s], qf[s], st);
    return st;
}
DI f32x16 qk2(const bf16x8& k0, const bf16x8& k1, const bf16x8& q0, const bf16x8& q1) { f32x16 st = zero16(); st = MFMA32(k0, q0, st); st = MFMA32(k1, q1, st); return st; }
DI void load_vf(bf16x8 (&vf)[2][2], const bf16_t* vt, int LD) {
#pragma unroll
    for (int db = 0; db < 2; ++db)
#pragma unroll
        for (int s = 0; s < 2; ++s) { const bf16_t* p = vt + (size_t)db * 32 * LD + 16 * s; const s16x4 a = *(const s16x4*)p; const s16x4 b = *(const s16x4*)(p + 8);
            vf[db][s] = __builtin_shufflevector(a, b, 0, 1, 2, 3, 4, 5, 6, 7); }
}
DI void apply_mask(f32x16& st, int kidx0, int lo, int hi, int h) {
#pragma unroll
    for (int i = 0; i < 16; ++i) { const int kid = kidx0 + crow(i, h); st[i] = (kid >= lo && kid <= hi) ? st[i] : -1e30f; }
}
DI void softmax_pv(f32x16 st, float& m, float& l, f32x16& oa, f32x16& ob, float c, const bf16x8 (&vf)[2][2], float bias = 0.f) {
    float mx = fmaxf(fmaxf(fmaxf(st[0], st[1]), fmaxf(st[2], st[3])), fmaxf(fmaxf(st[4], st[5]), fmaxf(st[6], st[7])));
    mx = fmaxf(mx, fmaxf(fmaxf(fmaxf(st[8], st[9]), fmaxf(st[10], st[11])), fmaxf(fmaxf(st[12], st[13]), fmaxf(st[14], st[15]))));
    mx = fmaxf(mx, __shfl_xor(mx, 32));
    const float mnew = fmaxf(m, mx * c + bias);
    if (__ballot(mnew > m) != 0ull) {
        const float alpha = __builtin_amdgcn_exp2f(m - mnew);
        m = mnew; l *= alpha;
#pragma unroll
        for (int i = 0; i < 16; ++i) { oa[i] *= alpha; ob[i] *= alpha; }
    }
    float rs = 0.f;
    const float nmb = bias - m;
#pragma unroll
    for (int i = 0; i < 16; ++i) { const float p = __builtin_amdgcn_exp2f(__builtin_fmaf(st[i], c, nmb)); st[i] = p; rs += p; }
    rs += __shfl_xor(rs, 32);
    l += rs;
#pragma unroll
    for (int s = 0; s < 2; ++s) {
        u32x4 pw; pw.x = pk2(st[8 * s], st[8 * s + 1]); pw.y = pk2(st[8 * s + 2], st[8 * s + 3]); pw.z = pk2(st[8 * s + 4], st[8 * s + 5]); pw.w = pk2(st[8 * s + 6], st[8 * s + 7]);
        const bf16x8 pb = __builtin_bit_cast(bf16x8, pw);
        oa = MFMA32(vf[0][s], pb, oa); ob = MFMA32(vf[1][s], pb, ob);
    }
}
DI void lds_kf(bf16x8 (&kf)[4], const LAS bf16_t* Kt, int sb, int r, int h) {
#pragma unroll
    for (int s = 0; s < 4; ++s) kf[s] = *(const LAS bf16x8*)(Kt + (32 * sb + r) * 72 + 16 * s + 8 * h);
}
DI void lds_vf(bf16x8 (&vf)[2][2], const LAS bf16_t* Vt, int sb, int r, int h) {
#pragma unroll
    for (int db = 0; db < 2; ++db)
#pragma unroll
        for (int s = 0; s < 2; ++s) { const LAS bf16_t* p = Vt + (32 * db + r) * 72 + 32 * sb + 16 * s + 4 * h; const s16x4 a = *(const LAS s16x4*)p; const s16x4 b = *(const LAS s16x4*)(p + 8);
            vf[db][s] = __builtin_shufflevector(a, b, 0, 1, 2, 3, 4, 5, 6, 7); }
}
#define ATT_BAR() do { asm volatile("s_waitcnt lgkmcnt(0)" ::: "memory"); __builtin_amdgcn_s_barrier(); asm volatile("" ::: "memory"); } while (0)
constexpr int ATT_TILE = 64 * 72;
constexpr int ATT_BUF = 2 * ATT_TILE;
constexpr int ATT_FLAGS = 8 * ATT_TILE * 2;
DI void store_o(bf16_t* orow, const f32x16& oa, const f32x16& ob, float sc, int h) {
#pragma unroll
    for (int g4 = 0; g4 < 4; ++g4) {
        u32x2 w; w.x = pk2(oa[4 * g4] * sc, oa[4 * g4 + 1] * sc); w.y = pk2(oa[4 * g4 + 2] * sc, oa[4 * g4 + 3] * sc);
        *(u32x2*)(orow + 8 * g4 + 4 * h) = w;
        u32x2 w2; w2.x = pk2(ob[4 * g4] * sc, ob[4 * g4 + 1] * sc); w2.y = pk2(ob[4 * g4 + 2] * sc, ob[4 * g4 + 3] * sc);
        *(u32x2*)(orow + 32 + 8 * g4 + 4 * h) = w2;
    }
}
DI void store_o_rows(bf16_t* orow, size_t rstride, const f32x16& oa, const f32x16& ob, float sc, int lane, LAS bf16_t* stg) {
    const int r = lane & 31, h = lane >> 5;
    bf16_t* row0 = orow - (size_t)r * rstride;
#pragma unroll
    for (int g4 = 0; g4 < 4; ++g4) {
        u32x2 w; w.x = pk2(oa[4 * g4] * sc, oa[4 * g4 + 1] * sc); w.y = pk2(oa[4 * g4 + 2] * sc, oa[4 * g4 + 3] * sc);
        *(LAS u32x2*)(stg + r * 72 + 8 * g4 + 4 * h) = w;
        u32x2 w2; w2.x = pk2(ob[4 * g4] * sc, ob[4 * g4 + 1] * sc); w2.y = pk2(ob[4 * g4 + 2] * sc, ob[4 * g4 + 3] * sc);
        *(LAS u32x2*)(stg + r * 72 + 32 + 8 * g4 + 4 * h) = w2;
    }
    asm volatile("s_waitcnt lgkmcnt(0)" ::: "memory");
#pragma unroll
    for (int i = 0; i < 4; ++i) { const int row = (lane >> 3) + 8 * i; const bf16x8 v = *(const LAS bf16x8*)(stg + row * 72 + (lane & 7) * 8);
        *(bf16x8*)(row0 + (size_t)row * rstride + (lane & 7) * 8) = v; }
    asm volatile("s_waitcnt lgkmcnt(0)" ::: "memory");
}
#define O_STG(c) ((LAS bf16_t*)((c).lds + 81920 + (c).wave * 4608))
constexpr int BIGI = 1 << 29;

DI void attn_A_unit(const Ctx& c, int b, int hd, int u, float lam, float lam_init, const float* subln) {
    const int lane = c.lane, r = lane & 31, h = lane >> 5, w = c.wave, qt = 8 * u + w;
    const bf16_t* QKV = (const bf16_t*)(c.p->ws + WS_BIG);
    const size_t tok_q = (size_t)b * SEQ + qt * 32 + r;
    const bf16_t* qrow = QKV + tok_q * NQKV + COL_QA + hd * 64 + 8 * h;
    bf16x8 qf[4];
#pragma unroll
    for (int s = 0; s < 4; ++s) qf[s] = *(const bf16x8*)(qrow + 16 * s);
    const int trow = c.tid >> 3, tch = (c.tid & 7) * 8;
    const bf16_t* kg = QKV + ((size_t)b * SEQ + trow) * NQKV + COL_KA + hd * 64 + tch;
    const bf16_t* vg = (const bf16_t*)(c.p->ws + WS_VT) + ((size_t)(hd * 16 + b) * 64 + trow) * SEQ + tch;
    LAS bf16_t* L = (LAS bf16_t*)c.lds;
    const int loff = trow * 72 + tch;
    float m1 = -1e30f, l1 = 0.f, m2 = -1e30f, l2 = 0.f;
    f32x16 o1a = zero16(), o1b = zero16(), o2a = zero16(), o2b = zero16();
    const float sc = 0.17677669529663687f * LOG2E;
    const int qidx = qt * 32 + r, nt = 4 * u + 4;
    bf16x8 kr = *(const bf16x8*)kg, vr = *(const bf16x8*)vg;
    *(LAS bf16x8*)(L + loff) = kr; *(LAS bf16x8*)(L + ATT_TILE + loff) = vr;
    __syncthreads();
    for (int t = 0; t < nt; ++t) {
        if (t + 1 < nt) { kr = *(const bf16x8*)(kg + (size_t)(t + 1) * 64 * NQKV); vr = *(const bf16x8*)(vg + (t + 1) * 64); }
        const LAS bf16_t* Kt = L + (t & 1) * ATT_BUF; const LAS bf16_t* Vt = Kt + ATT_TILE;
#pragma unroll
        for (int sb = 0; sb < 2; ++sb) {
            const int kb = 2 * t + sb;
            if (kb <= qt) {
                bf16x8 kf[4], vf[2][2]; lds_kf(kf, Kt, sb, r, h); lds_vf(vf, Vt, sb, r, h);
                f32x16 st1 = qk2(kf[0], kf[1], qf[0], qf[1]);
                f32x16 st2 = qk2(kf[2], kf[3], qf[2], qf[3]);
                if (kb == qt) { apply_mask(st1, kb * 32, -BIGI, qidx, h); apply_mask(st2, kb * 32, -BIGI, qidx, h); }
                softmax_pv(st1, m1, l1, o1a, o1b, sc, vf);
                softmax_pv(st2, m2, l2, o2a, o2b, sc, vf);
            }
        }
        if (t + 1 < nt) { LAS bf16_t* Ln = L + ((t + 1) & 1) * ATT_BUF; *(LAS bf16x8*)(Ln + loff) = kr; *(LAS bf16x8*)(Ln + ATT_TILE + loff) = vr; }
        __syncthreads();
    }
    const float i1 = 1.0f / l1, i2 = lam / l2;
    float ss = 0.f;
#pragma unroll
    for (int i = 0; i < 16; ++i) { o1a[i] = o1a[i] * i1 - o2a[i] * i2; o1b[i] = o1b[i] * i1 - o2b[i] * i2; ss += o1a[i] * o1a[i] + o1b[i] * o1b[i]; }
    ss += __shfl_xor(ss, 32);
    const float rn = (1.0f / sqrtf(ss * (1.f / 64.f) + EPS)) * (1.0f - lam_init);
#pragma unroll
    for (int i = 0; i < 16; ++i) { const int dm = crow(i, h); o1a[i] *= subln[dm]; o1b[i] *= subln[32 + dm]; }
    bf16_t* orow = (bf16_t*)(c.p->ws + WS_MIXED) + tok_q * D + hd * 64;
    store_o_rows(orow, D, o1a, o1b, rn, lane, O_STG(c));
}

DI void attn_B_item(const Ctx& c, int br, int b, int hd, int tile) {
    const int lane = c.lane, r = lane & 31, h = lane >> 5;
    const int dsh = 2 * br, d = 1 << dsh, L = SEQ >> dsh, tpr = L >> 5;
    const int rr = tile / tpr, mt = tile % tpr, m0 = mt * 32, mq = m0 + r;
    const bf16_t* QKV = (const bf16_t*)(c.p->ws + WS_BIG);
    const size_t tok_q = (size_t)b * SEQ + mq * d + rr;
    const bf16_t* qrow = QKV + tok_q * NQKV + COL_QB + hd * 64 + 8 * h;
    bf16x8 qf[4];
#pragma unroll
    for (int s = 0; s < 4; ++s) qf[s] = *(const bf16x8*)(qrow + 16 * s);
    const bf16_t* kbase = QKV + ((size_t)b * SEQ + rr + (size_t)r * d) * NQKV + COL_KB + hd * 64 + 8 * h;
    const bf16_t* vt = (const bf16_t*)(c.p->ws + WS_VT) + ((size_t)((10 + hd * 3 + br) * 16 + b) * 64 + r) * SEQ + rr * L + 4 * h;
    float m = -1e30f, l = 0.f; f32x16 oa = zero16(), ob = zero16();
    const float sc = 0.125f * LOG2E;
    int kstart = m0 - 128; if (kstart < 0) kstart = 0;
    bf16x8 kf[4]; load_kf(kf, kbase + (size_t)kstart * d * NQKV);
    bf16x8 vf[2][2]; load_vf(vf, vt + kstart, SEQ);
    for (int kidx0 = kstart; kidx0 <= m0; kidx0 += 32) {
        const int knext = kidx0 < m0 ? kidx0 + 32 : kidx0;
        bf16x8 kn[4]; load_kf(kn, kbase + (size_t)knext * d * NQKV);
        bf16x8 vn[2][2]; load_vf(vn, vt + knext, SEQ);
        f32x16 st = qk4(kf, qf);
        if (kidx0 < m0 - 97 || kidx0 > m0 - 31) apply_mask(st, kidx0, mq - 128, mq, h);
        softmax_pv(st, m, l, oa, ob, sc, vf);
#pragma unroll
        for (int s = 0; s < 4; ++s) kf[s] = kn[s];
#pragma unroll
        for (int a = 0; a < 2; ++a)
#pragma unroll
            for (int s = 0; s < 2; ++s) vf[a][s] = vn[a][s];
    }
    bf16_t* orow = (bf16_t*)(c.p->ws + WS_H) + ((size_t)br * MTOK + tok_q) * 384 + hd * 64;
    store_o(orow, oa, ob, 1.0f / l, h);
    if (h == 0) ((float*)(c.p->ws + WS_LSE))[((size_t)br * MTOK + tok_q) * 6 + hd] = m + __builtin_amdgcn_logf(l);
}

DI void attn_B_unit(const Ctx& c, int br, int b, int hd, int rr, int U) {
    const int lane = c.lane, r = lane & 31, h = lane >> 5, w = c.wave;
    const int dsh = 2 * br, d = 1 << dsh, L = SEQ >> dsh;
    const int mt = 8 * U + w, m0 = 32 * mt, mq = m0 + r;
    const bf16_t* QKV = (const bf16_t*)(c.p->ws + WS_BIG);
    const size_t tok_q = (size_t)b * SEQ + mq * d + rr;
    const bf16_t* qrow = QKV + tok_q * NQKV + COL_QB + hd * 64 + 8 * h;
    bf16x8 qf[4];
#pragma unroll
    for (int s = 0; s < 4; ++s) qf[s] = *(const bf16x8*)(qrow + 16 * s);
    const int trow = c.tid >> 3, tch = (c.tid & 7) * 8;
    const bf16_t* kg = QKV + ((size_t)b * SEQ + rr + (size_t)trow * d) * NQKV + COL_KB + hd * 64 + tch;
    const bf16_t* vg = (const bf16_t*)(c.p->ws + WS_VT) + ((size_t)((10 + hd * 3 + br) * 16 + b) * 64 + trow) * SEQ + rr * L + tch;
    LAS bf16_t* Lb = (LAS bf16_t*)c.lds;
    const int loff = trow * 72 + tch;
    const float sc = 0.125f * LOG2E;
    const int T0 = (4 * U - 2) < 0 ? 0 : (4 * U - 2), T1 = 4 * U + 3, ntile = T1 - T0 + 1;
    bf16x8 kq[6], vq[6];
#pragma unroll
    for (int j = 0; j < 6; ++j) { const int T = (j < ntile) ? T0 + j : T0; kq[j] = *(const bf16x8*)(kg + (size_t)T * 64 * d * NQKV); vq[j] = *(const bf16x8*)(vg + T * 64); }
    ATT_BAR();
#pragma unroll
    for (int j = 0; j < 6; ++j) { *(LAS bf16x8*)(Lb + j * ATT_BUF + loff) = kq[j]; *(LAS bf16x8*)(Lb + j * ATT_BUF + ATT_TILE + loff) = vq[j]; }
    ATT_BAR();
    float m = -1e30f, l = 0.f; f32x16 oa = zero16(), ob = zero16();
    int kb0 = mt - 4; if (kb0 < 0) kb0 = 0;
    for (int kb = kb0; kb <= mt; ++kb) {
        const LAS bf16_t* Kt = Lb + ((kb >> 1) - T0) * ATT_BUF; const LAS bf16_t* Vt = Kt + ATT_TILE;
        bf16x8 kf[4], vf[2][2]; lds_kf(kf, Kt, kb & 1, r, h); lds_vf(vf, Vt, kb & 1, r, h);
        f32x16 st = qk4(kf, qf);
        if (kb == mt - 4 || kb == mt) apply_mask(st, kb * 32, mq - 128, mq, h);
        softmax_pv(st, m, l, oa, ob, sc, vf);
    }
    ATT_BAR();
    bf16_t* orow = (bf16_t*)(c.p->ws + WS_H) + ((size_t)br * MTOK + tok_q) * 384 + hd * 64;
    store_o_rows(orow, (size_t)d * 384, oa, ob, 1.0f / l, lane, O_STG(c));
    if (h == 0) ((float*)(c.p->ws + WS_LSE))[((size_t)br * MTOK + tok_q) * 6 + hd] = m + __builtin_amdgcn_logf(l);
}

DI void attn_B2_unit(const Ctx& c, int b, int hd, int rp) {
    const int lane = c.lane, r = lane & 31, h = lane >> 5, w = c.wave;
    const int ri = w >> 2, mt = w & 3, rr = 2 * rp + ri, m0 = 32 * mt, mq = m0 + r;
    const bf16_t* QKV = (const bf16_t*)(c.p->ws + WS_BIG);
    const size_t tok_q = (size_t)b * SEQ + mq * 16 + rr;
    const bf16_t* qrow = QKV + tok_q * NQKV + COL_QB + hd * 64 + 8 * h;
    bf16x8 qf[4];
#pragma unroll
    for (int s = 0; s < 4; ++s) qf[s] = *(const bf16x8*)(qrow + 16 * s);
    const int trow = c.tid >> 3, tch = (c.tid & 7) * 8;
    LAS bf16_t* Lb = (LAS bf16_t*)c.lds;
    const int loff = trow * 72 + tch;
    bf16x8 kr[4], vr[4];
#pragma unroll
    for (int i = 0; i < 4; ++i) { const int ri2 = i >> 1, kt = i & 1, rr2 = 2 * rp + ri2;
        kr[i] = *(const bf16x8*)(QKV + ((size_t)b * SEQ + rr2 + (size_t)(64 * kt + trow) * 16) * NQKV + COL_KB + hd * 64 + tch);
        vr[i] = *(const bf16x8*)((const bf16_t*)(c.p->ws + WS_VT) + ((size_t)((10 + hd * 3 + 2) * 16 + b) * 64 + trow) * SEQ + rr2 * 128 + 64 * kt + tch); }
#pragma unroll
    for (int i = 0; i < 4; ++i) { *(LAS bf16x8*)(Lb + (2 * i) * ATT_TILE + loff) = kr[i]; *(LAS bf16x8*)(Lb + (2 * i + 1) * ATT_TILE + loff) = vr[i]; }
    __syncthreads();
    float m = -1e30f, l = 0.f; f32x16 oa = zero16(), ob = zero16();
    const float sc = 0.125f * LOG2E;
    for (int kb = 0; kb <= mt; ++kb) {
        const LAS bf16_t* Kt = Lb + (2 * (ri * 2 + (kb >> 1))) * ATT_TILE; const LAS bf16_t* Vt = Kt + ATT_TILE;
        bf16x8 kf[4], vf[2][2]; lds_kf(kf, Kt, kb & 1, r, h); lds_vf(vf, Vt, kb & 1, r, h);
        f32x16 st = qk4(kf, qf);
        if (kb == mt) apply_mask(st, kb * 32, -BIGI, mq, h);
        softmax_pv(st, m, l, oa, ob, sc, vf);
    }
    __syncthreads();
    bf16_t* orow = (bf16_t*)(c.p->ws + WS_H) + ((size_t)2 * MTOK + tok_q) * 384 + hd * 64;
    store_o_rows(orow, (size_t)16 * 384, oa, ob, 1.0f / l, lane, O_STG(c));
    if (h == 0) ((float*)(c.p->ws + WS_LSE))[((size_t)2 * MTOK + tok_q) * 6 + hd] = m + __builtin_amdgcn_logf(l);
}

DI void attn_C_unit(const Ctx& c, int b, int hd, int qb) {
    const int lane = c.lane, r = lane & 31, h = lane >> 5, w = c.wave, qt = 8 * qb + w;
    const bf16_t* QKV = (const bf16_t*)(c.p->ws + WS_BIG);
    const size_t tok_q = (size_t)b * SEQ + qt * 32 + r;
    const bf16_t* qrow = QKV + tok_q * NQKV + COL_QC + hd * 64 + 8 * h;
    bf16x8 qf[4];
#pragma unroll
    for (int s = 0; s < 4; ++s) qf[s] = *(const bf16x8*)(qrow + 16 * s);
    const float* km = (const float*)(c.p->ws + WS_MISC + 4096) + (size_t)(b * 6 + hd) * 8 * 64 + 8 * h;
    float g[7];
#pragma unroll
    for (int n = 0; n < 7; ++n) {
        float dot = 0.f;
        if (n < qb) {
#pragma unroll
            for (int s = 0; s < 4; ++s)
#pragma unroll
                for (int j = 0; j < 8; ++j) dot += bf2f(qf[s][j]) * km[n * 64 + 16 * s + j];
        }
        dot += __shfl_xor(dot, 32);
        g[n] = (n < qb) ? dot : -__builtin_inff();
    }
    unsigned selmask = 0, wavemask = 0;
#pragma unroll
    for (int n = 0; n < 7; ++n) {
        int cnt = 0;
#pragma unroll
        for (int n2 = 0; n2 < 7; ++n2) if (n2 != n) cnt += (g[n2] > g[n] || (g[n2] == g[n] && n2 < n)) ? 1 : 0;
        const bool sel = (n < qb && cnt < 3);
        if (sel) selmask |= 1u << n;
        if (__ballot(sel) != 0ull) wavemask |= 1u << n;
    }
    LAS int* flags = (LAS int*)(c.lds + ATT_FLAGS);
    if (lane == 0) flags[w] = (int)wavemask;
    __syncthreads();
    unsigned um = 0;
#pragma unroll
    for (int i = 0; i < 8; ++i) um |= (unsigned)flags[i];
    um = __builtin_amdgcn_readfirstlane(um);
    const int nt = 4 + 4 * __builtin_popcount(um);
    const int trow = c.tid >> 3, tch = (c.tid & 7) * 8;
    const bf16_t* kg = QKV + ((size_t)b * SEQ + trow) * NQKV + COL_KC + hd * 64 + tch;
    const bf16_t* vg = (const bf16_t*)(c.p->ws + WS_VT) + ((size_t)((4 + hd) * 16 + b) * 64 + trow) * SEQ + tch;
    LAS bf16_t* L = (LAS bf16_t*)c.lds;
    const int loff = trow * 72 + tch;
    float m = -1e30f, l = 0.f; f32x16 oa = zero16(), ob = zero16();
    const float sc = 0.125f * LOG2E;
    const int qidx = qt * 32 + r;
    const int np = nt >> 1;
    auto pair_tile = [&](int p) -> int { if (p < 2) return 4 * qb + 2 * p; unsigned rr_ = um; for (int i = (p - 2) >> 1; i > 0; --i) rr_ &= rr_ - 1; return 4 * __builtin_ctz(rr_) + 2 * ((p - 2) & 1); };
    int kt = 4 * qb;
    bf16x8 kr0 = *(const bf16x8*)(kg + (size_t)kt * 64 * NQKV), vr0 = *(const bf16x8*)(vg + kt * 64);
    bf16x8 kr1 = *(const bf16x8*)(kg + (size_t)(kt + 1) * 64 * NQKV), vr1 = *(const bf16x8*)(vg + (kt + 1) * 64);
    *(LAS bf16x8*)(L + loff) = kr0; *(LAS bf16x8*)(L + ATT_TILE + loff) = vr0; *(LAS bf16x8*)(L + ATT_BUF + loff) = kr1; *(LAS bf16x8*)(L + ATT_BUF + ATT_TILE + loff) = vr1;
    __syncthreads();
    for (int p = 0; p < np; ++p) {
        int ktn = kt;
        if (p + 1 < np) { ktn = pair_tile(p + 1);
            kr0 = *(const bf16x8*)(kg + (size_t)ktn * 64 * NQKV); vr0 = *(const bf16x8*)(vg + ktn * 64);
            kr1 = *(const bf16x8*)(kg + (size_t)(ktn + 1) * 64 * NQKV); vr1 = *(const bf16x8*)(vg + (ktn + 1) * 64); }
        const LAS bf16_t* G = L + (p & 1) * 2 * ATT_BUF;
        const bool own = p < 2;
        const int nblk = kt >> 2;
        const int mysel = (selmask >> nblk) & 1;
        const bool wave_need = own || (((wavemask >> nblk) & 1) != 0);
        if (wave_need) {
            const float bias = (own || mysel) ? 0.f : -1e30f;
#pragma unroll
            for (int i = 0; i < 2; ++i) {
                const LAS bf16_t* Kt = G + i * ATT_BUF; const LAS bf16_t* Vt = Kt + ATT_TILE;
#pragma unroll
                for (int sb = 0; sb < 2; ++sb) {
                    const int kb = 2 * (kt + i) + sb;
                    if (!own || kb <= qt) {
                        bf16x8 kf[4], vf[2][2]; lds_kf(kf, Kt, sb, r, h); lds_vf(vf, Vt, sb, r, h);
                        f32x16 st = qk4(kf, qf);
                        if (own && kb == qt) apply_mask(st, kb * 32, -BIGI, qidx, h);
                        softmax_pv(st, m, l, oa, ob, sc, vf, bias);
                    }
                }
            }
        }
        if (p + 1 < np) { LAS bf16_t* Gn = L + ((p + 1) & 1) * 2 * ATT_BUF;
            *(LAS bf16x8*)(Gn + loff) = kr0; *(LAS bf16x8*)(Gn + ATT_TILE + loff) = vr0; *(LAS bf16x8*)(Gn + ATT_BUF + loff) = kr1; *(LAS bf16x8*)(Gn + ATT_BUF + ATT_TILE + loff) = vr1; }
        __syncthreads();
        kt = ktn;
    }
    bf16_t* orow = (bf16_t*)(c.p->ws + WS_MIXED) + tok_q * D + 640 + hd * 64;
    store_o_rows(orow, D, oa, ob, 1.0f / l, lane, O_STG(c));
}

DI void attn_M_item(const Ctx& c, int b, int hd, int qt) {
    const int lane = c.lane, r = lane & 31, h = lane >> 5;
    const unsigned char* big = c.p->ws + WS_BIG;
    const size_t tok_q = (size_t)b * SEQ + qt * 32 + r;
    const bf16_t* qrow = (const bf16_t*)(big + BIG_QM) + tok_q * 256 + hd * 64 + 8 * h;
    bf16x8 qf[4];
#pragma unroll
    for (int s = 0; s < 4; ++s) qf[s] = *(const bf16x8*)(qrow + 16 * s);
    const bf16_t* kbase = (const bf16_t*)(c.p->ws + WS_KVM) + ((size_t)b * MEMLEN + r) * 512 + hd * 64 + 8 * h;
    const bf16_t* vt = (const bf16_t*)(c.p->ws + WS_VTM) + ((size_t)(b * 4 + hd) * 64 + r) * MEMLEN + 4 * h;
    float m = -1e30f, l = 0.f; f32x16 oa = zero16(), ob = zero16();
    const float sc = 0.125f * LOG2E;
    bf16x8 kf[4]; load_kf(kf, kbase);
    for (int kb = 0; kb < 8; ++kb) {
        const int kidx0 = kb * 32;
        bf16x8 vf[2][2]; load_vf(vf, vt + kidx0, MEMLEN);
        bf16x8 kn[4]; load_kf(kn, kbase + (size_t)(kb < 7 ? kidx0 + 32 : kidx0) * 512);
        const f32x16 st = qk4(kf, qf);
        softmax_pv(st, m, l, oa, ob, sc, vf);
#pragma unroll
        for (int s = 0; s < 4; ++s) kf[s] = kn[s];
    }
    bf16_t* orow = (bf16_t*)(big + BIG_OM) + tok_q * 256 + hd * 64;
    store_o_rows(orow, 256, oa, ob, 1.0f / l, lane, O_STG(c));
}

constexpr int PH_CONV = 0, PH_GU1 = 1, PH_DN1 = 2, PH_WIN = 3, PH_POST = 4, PH_ATT = 5, PH_MERGE = 6, PH_WOUT = 7, PH_MQ = 8, PH_MATT = 9,
              PH_MO = 10, PH_GU2 = 11, PH_DN2 = 12, PH_PER_LAYER = 13, PH_FINAL = 2 * PH_PER_LAYER, PH_TOTAL = PH_FINAL + 1;

DI float lam_init_of(int l) { return l == 0 ? 0.2f : 0.8f - 0.6f * 0.7408182206817179f; }
DI float* ssq_buf(unsigned char* ws, int l, int k) { return (float*)(ws + WS_SSQ) + (size_t)(l * 4 + k) * MTOK; }

DI void phase_conv(const Ctx& c) {
    CParams& P = *c.p; const int l = c.l;
    bf16_t* Wb = (bf16_t*)(P.ws + WS_W);
    LAS float* scr = (LAS float*)(c.lds + c.wave * 8448);
    constexpr int I_G = (D / 64) * (FF / 32), I_D = (FF / 64) * (D / 32), I_IN = (D / 64) * (NQKV / 32), I_OUT = (D / 64) * (D / 32), I_MQ = (D / 64) * (256 / 32),
                  I_MKV = (D / 64) * (512 / 32), I_MO = (256 / 64) * (D / 32);
    constexpr int NITEMS = 4 * I_G + 2 * I_D + I_IN + I_OUT + I_MQ + I_MKV + I_MO;
    const float* g1 = P.in[3] + (size_t)l * D; const float* g2 = P.in[20] + (size_t)l * D; const float* gm = P.in[7] + (size_t)l * D; const float* gq = P.in[15] + (size_t)l * D;
    for (int it = c.gw; it < NITEMS; it += c.ngw) {
        int r = it;
        if (r < I_G) { transpose_item(P.in[4] + (size_t)l * D * FF, D, FF, Wb + W_GU1, 3, 0, scr, r, c.lane, g1); continue; } r -= I_G;
        if (r < I_G) { transpose_item(P.in[5] + (size_t)l * D * FF, D, FF, Wb + W_GU1, 3, 4, scr, r, c.lane, g1); continue; } r -= I_G;
        if (r < I_D) { transpose_item(P.in[6] + (size_t)l * D * FF, FF, D, Wb + W_DN1, 2, 0, scr, r, c.lane); continue; } r -= I_D;
        if (r < I_G) { transpose_item(P.in[21] + (size_t)l * D * FF, D, FF, Wb + W_GU2, 3, 0, scr, r, c.lane, g2); continue; } r -= I_G;
        if (r < I_G) { transpose_item(P.in[22] + (size_t)l * D * FF, D, FF, Wb + W_GU2, 3, 4, scr, r, c.lane, g2); continue; } r -= I_G;
        if (r < I_D) { transpose_item(P.in[23] + (size_t)l * D * FF, FF, D, Wb + W_DN2, 2, 0, scr, r, c.lane); continue; } r -= I_D;
        if (r < I_IN) { transpose_item(P.in[8] + (size_t)l * D * NQKV, D, NQKV, Wb + W_IN, 2, 0, scr, r, c.lane, gm); continue; } r -= I_IN;
        if (r < I_OUT) { transpose_item(P.in[9] + (size_t)l * D * D, D, D, Wb + W_OUT, 2, 0, scr, r, c.lane); continue; } r -= I_OUT;
        if (r < I_MQ) { transpose_item(P.in[17] + (size_t)l * D * 256, D, 256, Wb + W_MQ, 2, 0, scr, r, c.lane, gq); continue; } r -= I_MQ;
        if (r < I_MKV) { transpose_item(P.in[18] + (size_t)l * D * 512, D, 512, Wb + W_MKV, 2, 0, scr, r, c.lane); continue; } r -= I_MKV;
        transpose_item(P.in[19] + (size_t)l * 256 * D, 256, D, Wb + W_MO, 2, 0, scr, r, c.lane);
    }
    norm_phase(c, P.in[1], P.in[16] + (size_t)l * D, (bf16_t*)(P.ws + WS_MEMN), MROWS);
    if (l == 0) {
        bf16_t* XB = (bf16_t*)(P.ws + WS_H); float* ssq0 = ssq_buf(P.ws, 0, 0);
        for (int m = c.gw; m < MTOK; m += c.ngw) {
            const f32x4* xr = (const f32x4*)(P.in[0] + (size_t)m * D) + c.lane; u32x2* o8 = (u32x2*)(XB + (size_t)m * D) + c.lane; float sq = 0.f;
#pragma unroll
            for (int j = 0; j < 4; ++j) { const f32x4 v = xr[64 * j]; sq += (v.x * v.x + v.y * v.y) + (v.z * v.z + v.w * v.w); u32x2 w; w.x = pk2(v.x, v.y); w.y = pk2(v.z, v.w); o8[64 * j] = w; }
            sq = wave_sum(sq); if (c.lane == 0) ssq0[m] = sq;
        }
        const int gt = c.bid * 512 + c.tid, ngt = c.G * 512;
        for (int i = gt; i < 7 * MTOK; i += ngt) ssq0[MTOK + i] = 0.f;
        const int* pos = (const int*)P.in[2];
        float* cosH = (float*)(P.ws + WS_COSH); float* sinH = (float*)(P.ws + WS_SINH); float* cosA = (float*)(P.ws + WS_COSA); float* sinA = (float*)(P.ws + WS_SINA);
        for (int i = gt; i < MTOK * 8; i += ngt) { const int t = i >> 3, f = i & 7; const float invf = powf(500000.0f, -(float)(2 * f) / 16.0f); const float ang = (float)pos[t] * invf;
            float sn, cs; sincosf(ang, &sn, &cs); cosH[i] = cs; sinH[i] = sn; }
        for (int i = gt; i < MTOK * 4; i += ngt) { const int t = i >> 2, f = i & 3; const float invf = powf(500000.0f, -(float)(2 * f) / 8.0f); const float ang = (float)pos[t] * invf;
            float sn, cs; sincosf(ang, &sn, &cs); cosA[i] = cs; sinA[i] = sn; }
        if (c.bid == 0 && c.wave == 0) {
            unsigned* cnt = (unsigned*)(P.ws + WS_MISC);
            cnt[c.lane] = 0u;
            float* lamp = (float*)(P.ws + WS_MISC + 256);
            for (int ll = 0; ll < 2; ++ll) {
                float a = 0.f, bsum = 0.f;
                if (c.lane < 32) { a = P.in[10][ll * 32 + c.lane] * P.in[11][ll * 32 + c.lane]; bsum = P.in[12][ll * 32 + c.lane] * P.in[13][ll * 32 + c.lane]; }
                a = wave_sum(a); bsum = wave_sum(bsum);
                if (c.lane == 0) lamp[ll] = expf(a) - expf(bsum) + lam_init_of(ll);
            }
        }
    }
}

DI void kmean_item(const Ctx& c, int item) {
    CParams& P = *c.p; const int lane = c.lane;
    const int qr = item & 3, it4 = item >> 2, hd = it4 >> 7, tb = it4 & 127, tok0 = tb * 256 + qr * 64;
    bf16_t* base = (bf16_t*)(P.ws + WS_BIG) + (size_t)tok0 * NQKV + COL_KC + hd * 64 + lane;
    const float* cosT = (const float*)(P.ws + WS_COSH); const float* sinT = (const float*)(P.ws + WS_SINH);
    const bool rot = lane < 16, first = lane < 8; const int fi = lane & 7;
    float sum = 0.f;
    for (int t0 = 0; t0 < 64; t0 += 16) {
        float own[16], cs[16], sn[16];
#pragma unroll
        for (int j = 0; j < 16; ++j) { own[j] = bfu2f(base[(size_t)(t0 + j) * NQKV]); cs[j] = rot ? cosT[(size_t)(tok0 + t0 + j) * 8 + fi] : 1.f; sn[j] = rot ? sinT[(size_t)(tok0 + t0 + j) * 8 + fi] : 0.f; }
#pragma unroll
        for (int j = 0; j < 16; ++j) {
            const float par = __shfl_xor(own[j], 8);
            float v = own[j];
            if (rot) { v = first ? (own[j] * cs[j] - par * sn[j]) : (own[j] * cs[j] + par * sn[j]); base[(size_t)(t0 + j) * NQKV] = f2bf(v); }
            sum += v;
        }
    }
    const int b = tb >> 3, n = tb & 7; atomicAdd((float*)(P.ws + WS_MISC + 4096) + ((size_t)(b * 6 + hd) * 8 + n) * 64 + lane, sum * (1.0f / 256.0f));
}

DI void rot_fast(const Ctx& c) {
    CParams& P = *c.p;
    bf16_t* QKV = (bf16_t*)(P.ws + WS_BIG);
    const float* cosH = (const float*)(P.ws + WS_COSH); const float* sinH = (const float*)(P.ws + WS_SINH); const float* cosA = (const float*)(P.ws + WS_COSA); const float* sinA = (const float*)(P.ws + WS_SINA);
    const int gt = c.bid * 512 + c.tid, ngt = c.G * 512;
    for (int i0 = gt; i0 < MTOK * 18; i0 += 4 * ngt) {
        bf16x8 a[4], b[4]; f32x4 c0[4], c1[4], s0[4], s1[4]; bf16_t* pp[4];
#pragma unroll
        for (int u = 0; u < 4; ++u) { const int i = i0 + u * ngt; const bool ok = i < MTOK * 18; const int ii = ok ? i : 0; const int tok = ii / 18, sl = ii % 18;
            const int col = sl < 6 ? COL_QB + sl * 64 : (sl < 12 ? COL_KB + (sl - 6) * 64 : COL_QC + (sl - 12) * 64);
            pp[u] = ok ? QKV + (size_t)tok * NQKV + col : nullptr;
            a[u] = *(const bf16x8*)(QKV + (size_t)tok * NQKV + col); b[u] = *(const bf16x8*)(QKV + (size_t)tok * NQKV + col + 8);
            const f32x4* cp = (const f32x4*)(cosH + (size_t)tok * 8); const f32x4* sp = (const f32x4*)(sinH + (size_t)tok * 8);
            c0[u] = cp[0]; c1[u] = cp[1]; s0[u] = sp[0]; s1[u] = sp[1]; }
#pragma unroll
        for (int u = 0; u < 4; ++u) {
            float o1[8], o2[8];
#pragma unroll
            for (int j = 0; j < 8; ++j) { const float x1 = bf2f(a[u][j]), x2 = bf2f(b[u][j]); const float cs = j < 4 ? c0[u][j & 3] : c1[u][j & 3], sn = j < 4 ? s0[u][j & 3] : s1[u][j & 3];
                o1[j] = x1 * cs - x2 * sn; o2[j] = x2 * cs + x1 * sn; }
            u32x4 w1, w2; w1.x = pk2(o1[0], o1[1]); w1.y = pk2(o1[2], o1[3]); w1.z = pk2(o1[4], o1[5]); w1.w = pk2(o1[6], o1[7]);
            w2.x = pk2(o2[0], o2[1]); w2.y = pk2(o2[2], o2[3]); w2.z = pk2(o2[4], o2[5]); w2.w = pk2(o2[6], o2[7]);
            if (pp[u]) { *(u32x4*)pp[u] = w1; *(u32x4*)(pp[u] + 8) = w2; }
        }
    }
    for (int i0 = gt; i0 < MTOK * 16; i0 += 4 * ngt) {
        bf16x8 a[4]; f32x4 c0[4], s0[4]; bf16_t* pp[4];
#pragma unroll
        for (int u = 0; u < 4; ++u) { const int i = i0 + u * ngt; const bool ok = i < MTOK * 16; const int ii = ok ? i : 0; const int tok = ii >> 4, sl = ii & 15;
            pp[u] = ok ? QKV + (size_t)tok * NQKV + sl * 32 : nullptr;
            a[u] = *(const bf16x8*)(QKV + (size_t)tok * NQKV + sl * 32);
            c0[u] = *(const f32x4*)(cosA + (size_t)tok * 4); s0[u] = *(const f32x4*)(sinA + (size_t)tok * 4); }
#pragma unroll
        for (int u = 0; u < 4; ++u) {
            float o[8];
#pragma unroll
            for (int j = 0; j < 4; ++j) { const float x1 = bf2f(a[u][j]), x2 = bf2f(a[u][4 + j]); o[j] = x1 * c0[u][j] - x2 * s0[u][j]; o[4 + j] = x2 * c0[u][j] + x1 * s0[u][j]; }
            u32x4 w; w.x = pk2(o[0], o[1]); w.y = pk2(o[2], o[3]); w.z = pk2(o[4], o[5]); w.w = pk2(o[6], o[7]);
            if (pp[u]) *(u32x4*)pp[u] = w;
        }
    }
}

DI void phase_post(const Ctx& c) {
    CParams& P = *c.p;
    constexpr int N_KM = 4 * 6 * 128, N_VT = 16 * 16 * 32;
    LAS bf16_t* tile = (LAS bf16_t*)(c.lds + c.wave * 9216);
    const bf16_t* QKV = (const bf16_t*)(P.ws + WS_BIG);
    for (int it = c.gw; it < N_KM + N_VT; it += c.ngw) {
        if (it < N_KM) { kmean_item(c, it); continue; }
        const int v = it - N_KM; const int sl = v / 512, rem = v % 512, b = rem >> 5, t0 = (rem & 31) * 64;
        bf16x8 vv[8];
        if (sl < 6) {
            vt_load(vv, QKV + ((size_t)b * SEQ + t0) * NQKV + COL_VB + sl * 64, NQKV, c.lane);
#pragma unroll
            for (int br = 0; br < 3; ++br) vt_item(vv, (bf16_t*)(P.ws + WS_VT) + (size_t)((10 + sl * 3 + br) * 16 + b) * 64 * SEQ, SEQ, t0, 2 * br, SEQ >> (2 * br), tile, c.lane);
        } else {
            const int slot = sl - 6; const int col = slot < 4 ? COL_VA + slot * 64 : COL_VC + (slot - 4) * 64;
            vt_load(vv, QKV + ((size_t)b * SEQ + t0) * NQKV + col, NQKV, c.lane);
            vt_item(vv, (bf16_t*)(P.ws + WS_VT) + (size_t)(slot * 16 + b) * 64 * SEQ, SEQ, t0, 0, SEQ, tile, c.lane);
        }
    }
    rot_fast(c);
}

DI void phase_att(const Ctx& c) {
    CParams& P = *c.p; const int l = c.l;
    unsigned* cnt = (unsigned*)(P.ws + WS_MISC) + 2 * l;
    const float lam = ((const float*)(P.ws + WS_MISC + 256))[l];
    const float lam_init = lam_init_of(l);
    const float* subln = P.in[14] + l * 64;
    LAS int* slot = (LAS int*)(c.lds + ATT_FLAGS + 64);
    for (;;) {
        if (c.tid == 0) slot[0] = (int)atomicAdd(cnt, 1u);
        __syncthreads();
        const int it = __builtin_amdgcn_readfirstlane(slot[0]);
        __syncthreads();
        if (it >= 8 * 160 + 3 * 768) break;
        if (it < 8 * 160) {
            const int lev = 7 - it / 160, sub = it % 160;
            if (sub < 64) attn_A_unit(c, sub >> 2, sub & 3, lev, lam, lam_init, subln);
            else { const int s2 = sub - 64; attn_C_unit(c, s2 / 6, s2 % 6, lev); }
        } else {
            const int v0 = it - 8 * 160; const int br = v0 / 768, v = v0 % 768; const int b = v / 48, rem = v % 48, hd = rem >> 3, x = rem & 7;
            if (br < 2) attn_B_unit(c, br, b, hd, br == 0 ? 0 : (x >> 1), br == 0 ? x : (x & 1));
            else attn_B2_unit(c, b, hd, x);
        }
    }
#if 0
    constexpr int N2 = 16 * 6 * 64;
    for (;;) {
        int it = 0;
        if (c.lane == 0) it = (int)atomicAdd(cnt + 1, 1u);
        it = __builtin_amdgcn_readfirstlane(it);
        if (it >= N2) break;
        const int tile = it & 63, rest = it >> 6; const int hd = rest % 6, b = rest / 6;
        attn_B_item(c, 2, b, hd, tile);
    }
#endif
}

DI void phase_merge(const Ctx& c) {
    CParams& P = *c.p;
    const bf16_t* part = (const bf16_t*)(P.ws + WS_H); const float* lse = (const float*)(P.ws + WS_LSE); bf16_t* mixed = (bf16_t*)(P.ws + WS_MIXED);
    const int gt = c.bid * 512 + c.tid, ngt = c.G * 512;
    constexpr int NI = MTOK * 48;
    for (int i0 = gt; i0 < NI; i0 += 4 * ngt) {
        float lv[4][3]; bf16x8 pv[4][3]; bf16_t* dst[4];
#pragma unroll
        for (int u = 0; u < 4; ++u) { const int i = i0 + u * ngt; const bool ok = i < NI; const int ii = ok ? i : 0; const int tok = ii / 48, rem = ii % 48, hd = rem >> 3, g8 = rem & 7;
            dst[u] = ok ? mixed + (size_t)tok * D + 256 + hd * 64 + g8 * 8 : nullptr;
#pragma unroll
            for (int k = 0; k < 3; ++k) { lv[u][k] = lse[((size_t)k * MTOK + tok) * 6 + hd]; pv[u][k] = *(const bf16x8*)(part + ((size_t)k * MTOK + tok) * 384 + hd * 64 + g8 * 8); } }
#pragma unroll
        for (int u = 0; u < 4; ++u) {
            const float mx = fmaxf(lv[u][0], fmaxf(lv[u][1], lv[u][2]));
            float w0 = __builtin_amdgcn_exp2f(lv[u][0] - mx), w1 = __builtin_amdgcn_exp2f(lv[u][1] - mx), w2 = __builtin_amdgcn_exp2f(lv[u][2] - mx);
            const float inv = 1.0f / (w0 + w1 + w2); w0 *= inv; w1 *= inv; w2 *= inv;
            float o[8];
#pragma unroll
            for (int j = 0; j < 8; ++j) o[j] = w0 * bf2f(pv[u][0][j]) + w1 * bf2f(pv[u][1][j]) + w2 * bf2f(pv[u][2][j]);
            u32x4 w; w.x = pk2(o[0], o[1]); w.y = pk2(o[2], o[3]); w.z = pk2(o[4], o[5]); w.w = pk2(o[6], o[7]);
            if (dst[u]) *(u32x4*)dst[u] = w;
        }
    }
}

template <class Epi> DI void run_gemm(const Ctx& c, const bf16_t* A, const bf16_t* Bt, int M, int N, int K, const Epi& E, int off = 0) {
    pg8::Gemm g{A, Bt, M, N, K}; pg8::StaticOrder S; S.init(M, N, c.G, (c.bid + c.G - off) % c.G);
    pg8::gemm_phase<Epi, pg8::StaticOrder>(c.lds, g, S, E, c.tid);
}

__global__ void __launch_bounds__(512, 2) mega(Params Parg) {
    extern __shared__ __attribute__((aligned(16))) unsigned char lds_raw[];
    cg::grid_group grid = cg::this_grid();
    const int ph_lo = Parg.lo, ph_hi = Parg.hi;
#ifdef PROBE_MASK
    unsigned long long tacc = 0, tstart = 0; int qprev = -1;
#endif
    unsigned bar_gen = 0;
    for (int ph = ph_lo; ph < ph_hi; ++ph) {
        if (ph == ph_lo + 1) grid.sync();
        else if (ph != ph_lo) grid_barrier((unsigned*)(Parg.ws + WS_BAR), gridDim.x, bar_gen);
#ifdef PROBE_MASK
        { const unsigned long long tn = __builtin_amdgcn_s_memrealtime(); if (qprev >= 0 && ((PROBE_MASK >> qprev) & 1)) tacc += tn - tstart; tstart = tn; qprev = (ph == PH_FINAL) ? -1 : ph % PH_PER_LAYER; }
#endif
        int tid_l = threadIdx.x; asm volatile("" : "+v"(tid_l));
        unsigned long long kpu = (unsigned long long)__builtin_amdgcn_kernarg_segment_ptr(); asm volatile("" : "+s"(kpu));
        Ctx c; c.p = (CParams*)kpu; c.tid = tid_l; c.lane = c.tid & 63; c.wave = __builtin_amdgcn_readfirstlane(c.tid >> 6);
        int G_l = gridDim.x, bid_l = blockIdx.x; asm volatile("" : "+s"(G_l), "+s"(bid_l));
        c.G = G_l; c.bid = bid_l; c.gw = c.bid * 8 + c.wave; c.ngw = c.G * 8; c.lds = (LAS unsigned char*)lds_raw;
#define PHASE_BEGIN unsigned long long kpl_ = kpu; asm volatile("" : "+s"(kpl_)); c.p = (CParams*)kpl_; CParams& P = *c.p; unsigned char* ws = P.ws; \
        bf16_t* Wb = (bf16_t*)(ws + WS_W); bf16_t* XB = (bf16_t*)(ws + WS_H); bf16_t* ACT = (bf16_t*)(ws + WS_BIG); bf16_t* MIXED = (bf16_t*)(ws + WS_MIXED); (void)Wb; (void)XB; (void)ACT; (void)MIXED;
        if (ph == PH_FINAL) {
            PHASE_BEGIN
            for (int m = c.gw; m < MTOK; m += c.ngw) norm_row_f32(P.out + (size_t)m * D, P.in[24], P.out + (size_t)m * D, c.lane);
            continue;
        }
        const int l = ph / PH_PER_LAYER, q = ph % PH_PER_LAYER; c.l = l;
        switch (q) {
        case PH_CONV: { PHASE_BEGIN phase_conv(c); } break;
        case PH_GU1: { PHASE_BEGIN pg8::EpiSwiglu E{ACT, ssq_buf(ws, l, 0)}; run_gemm(c, XB, Wb + W_GU1, MTOK, 2 * FF, D, E); } break;
        case PH_DN1: { PHASE_BEGIN pg8::EpiResid E{(l == 0) ? P.in[0] : P.out, P.out, 0.5f, XB, ssq_buf(ws, l, 1)}; run_gemm(c, ACT, Wb + W_DN1, MTOK, D, FF, E); } break;
        case PH_WIN: { PHASE_BEGIN
            { float* kmz = (float*)(ws + WS_MISC + 4096); for (int i = c.bid * 512 + c.tid; i < 16 * 6 * 8 * 64; i += c.G * 512) kmz[i] = 0.f; }
            pg8::EpiStore E{ACT, NQKV, ssq_buf(ws, l, 1)}; run_gemm(c, XB, Wb + W_IN, MTOK, NQKV, D, E); } break;
        case PH_POST: { PHASE_BEGIN phase_post(c); } break;
        case PH_ATT: { PHASE_BEGIN phase_att(c); } break;
        case PH_MERGE: { PHASE_BEGIN phase_merge(c); } break;
        case PH_WOUT: { PHASE_BEGIN pg8::EpiResid E{P.out, P.out, 1.0f, XB, ssq_buf(ws, l, 2)}; run_gemm(c, MIXED, Wb + W_OUT, MTOK, D, D, E); } break;
        case PH_MQ: { PHASE_BEGIN
            pg8::EpiStore E{(bf16_t*)(ws + WS_BIG + BIG_QM), 256, ssq_buf(ws, l, 2)}; run_gemm(c, XB, Wb + W_MQ, MTOK, 256, D, E);
            pg8::EpiStoreKV E2{(bf16_t*)(ws + WS_KVM), (bf16_t*)(ws + WS_VTM)}; run_gemm(c, (const bf16_t*)(ws + WS_MEMN), Wb + W_MKV, MROWS, 512, D, E2, 128);
        } break;
        case PH_MATT: { PHASE_BEGIN } for (int it = c.gw; it < 16 * 4 * 64; it += c.ngw) attn_M_item(c, it >> 8, (it >> 6) & 3, it & 63); break;
        case PH_MO: { PHASE_BEGIN pg8::EpiResid E{P.out, P.out, 1.0f, XB, ssq_buf(ws, l, 3)}; run_gemm(c, (const bf16_t*)(ws + WS_BIG + BIG_OM), Wb + W_MO, MTOK, D, 256, E); } break;
        case PH_GU2: { PHASE_BEGIN pg8::EpiSwiglu E{ACT, ssq_buf(ws, l, 3)}; run_gemm(c, XB, Wb + W_GU2, MTOK, 2 * FF, D, E); } break;
        case PH_DN2: { PHASE_BEGIN pg8::EpiResid E{P.out, P.out, 0.5f, (l == 0) ? XB : nullptr, (l == 0) ? ssq_buf(ws, 1, 0) : nullptr}; run_gemm(c, ACT, Wb + W_DN2, MTOK, D, FF, E); } break;
        default: break;
        }
    }
#ifdef PROBE_MASK
    if (blockIdx.x == 0) { const unsigned long long tend = __builtin_amdgcn_s_memrealtime() + tacc * PROBE_MULT; while (__builtin_amdgcn_s_memrealtime() < tend) __builtin_amdgcn_s_sleep(32); }
#endif
}

constexpr int LDS_BYTES = 135168;

extern "C" void kernel_launch(void* const* d_in, const int* in_sizes, int n_in, void* d_out, int out_size, void* d_ws, size_t ws_size, hipStream_t stream) {
    static int grid = 0;
    if (grid == 0) {
        if (n_in != 25 || out_size != MTOK * D || ws_size < WS_END) { fprintf(stderr, "kernel_launch: unexpected shapes (n_in %d out %d ws %zu)\n", n_in, out_size, ws_size); grid = -1; return; }
        int dev = 0, cus = 0, per_cu = 0;
        hipGetDevice(&dev);
        hipDeviceGetAttribute(&cus, hipDeviceAttributeMultiprocessorCount, dev);
        if (hipFuncSetAttribute((const void*)mega, hipFuncAttributeMaxDynamicSharedMemorySize, LDS_BYTES) != hipSuccess) { fprintf(stderr, "kernel_launch: hipFuncSetAttribute failed\n"); grid = -1; return; }
        if (hipOccupancyMaxActiveBlocksPerMultiprocessor(&per_cu, (const void*)mega, 512, LDS_BYTES) != hipSuccess || per_cu < 1) { fprintf(stderr, "kernel_launch: occupancy query gave %d\n", per_cu); per_cu = 1; }
        (void)hipGetLastError();
        grid = cus * per_cu;
    }
    if (grid < 0) return;
    if (hipMemsetAsync((char*)d_ws + WS_BAR, 0, 1024, stream) != hipSuccess) { fprintf(stderr, "kernel_launch: memset failed\n"); return; }
    Params p{};
    for (int i = 0; i < 25; ++i) p.in[i] = (const float*)d_in[i];
    p.out = (float*)d_out; p.ws = (unsigned char*)d_ws;
#ifdef MK_PER_PHASE
    for (int ph = 0; ph < PH_TOTAL; ++ph) { p.lo = ph; p.hi = ph + 1; hipLaunchKernelGGL(mega, dim3(grid), dim3(512), LDS_BYTES, stream, p); }
#else
    p.lo = 0; p.hi = PH_TOTAL;
    void* args[] = {&p};
    hipError_t e = hipLaunchCooperativeKernel((const void*)mega, dim3(grid), dim3(512), args, LDS_BYTES, stream);
    if (e != hipSuccess) fprintf(stderr, "cooperative launch failed: %s (grid %d)\n", hipGetErrorString(e), grid);
#endif
}
```

```cpp
#include <hip/hip_runtime.h>
#include <hip/hip_cooperative_groups.h>
#include <cstdio>
#include <cstdint>
namespace cg = cooperative_groups;

#define DI __device__ __forceinline__
#define LAS __attribute__((address_space(3)))
typedef unsigned short bf16_t;
typedef short bf16x8 __attribute__((ext_vector_type(8)));
typedef short s16x4 __attribute__((ext_vector_type(4)));
typedef float f32x4 __attribute__((ext_vector_type(4)));
typedef float f32x2 __attribute__((ext_vector_type(2)));
typedef float f32x16 __attribute__((ext_vector_type(16)));
typedef unsigned u32x4 __attribute__((ext_vector_type(4)));
typedef unsigned u32x2 __attribute__((ext_vector_type(2)));
typedef __bf16 bf2_t __attribute__((ext_vector_type(2)));

constexpr int BATCH = 16, SEQ = 2048, D = 1024, MTOK = BATCH * SEQ, FF = 2816, MEMLEN = 256, MROWS = BATCH * MEMLEN, NQKV = 3072;
constexpr int COL_QA = 0, COL_KA = 256, COL_VA = 512, COL_QB = 768, COL_KB = 1152, COL_VB = 1536, COL_QC = 1920, COL_KC = 2304, COL_VC = 2688;
constexpr float EPS = 1e-6f;
constexpr float LOG2E = 1.4426950408889634f;

constexpr size_t MiB = 1u << 20;
constexpr size_t WS_MISC = 0;
constexpr size_t WS_BAR = 512 * 1024;
constexpr size_t WS_SSQ = 47 * MiB;
constexpr size_t WS_COSH = 1 * MiB, WS_SINH = 2 * MiB, WS_COSA = 3 * MiB, WS_SINA = 3 * MiB + 512 * 1024;
constexpr size_t WS_W = 4 * MiB;
constexpr size_t WS_H = 48 * MiB;
constexpr size_t WS_LSE = 120 * MiB;
constexpr size_t WS_BIG = 123 * MiB;
constexpr size_t WS_MIXED = 315 * MiB;
constexpr size_t WS_VT = 379 * MiB;
constexpr size_t WS_MEMN = 491 * MiB, WS_KVM = 499 * MiB, WS_VTM = 503 * MiB;
constexpr size_t WS_END = 505 * MiB;
constexpr size_t W_GU1 = 0, W_DN1 = W_GU1 + (size_t)2 * FF * D, W_GU2 = W_DN1 + (size_t)D * FF, W_DN2 = W_GU2 + (size_t)2 * FF * D,
                 W_IN = W_DN2 + (size_t)D * FF, W_OUT = W_IN + (size_t)NQKV * D, W_MQ = W_OUT + (size_t)D * D, W_MKV = W_MQ + (size_t)256 * D,
                 W_MO = W_MKV + (size_t)512 * D, W_ENDE = W_MO + (size_t)D * 256;
static_assert(W_ENDE * 2 <= 43 * MiB, "weights fit");
constexpr size_t BIG_QM = 16 * MiB, BIG_OM = 32 * MiB;

DI unsigned pk2(float a, float b) { f32x2 v = {a, b}; bf2_t r = __builtin_convertvector(v, bf2_t); return __builtin_bit_cast(unsigned, r); }
DI float bf2f(short s) { return __uint_as_float(((unsigned)(unsigned short)s) << 16); }
DI float bfu2f(bf16_t s) { return __uint_as_float(((unsigned)s) << 16); }
DI bf16_t f2bf(float f) { return (bf16_t)(pk2(f, 0.f) & 0xffffu); }
DI float wave_sum(float v) {
#pragma unroll
    for (int o = 1; o < 64; o <<= 1) v += __shfl_xor(v, o);
    return v;
}

namespace pg8 {
constexpr int BM = 256, BK = 64, HALF = 128, HTB = HALF * BK * 2, STAGE_BYTES = 8 * HTB, NXCD = 8, WGM = 8;
DI int lds_byte(int r, int c) { const int st = (r >> 4) * 2 + (c >> 5), rr = r & 15, cc = c & 31, ob = rr * 64 + cc * 2; return st * 1024 + (ob ^ (((ob >> 9) & 1) << 5)); }
DI void stage_rc(int b, int& R, int& C) { const int st = b / 1024, sb = b % 1024, swz = sb ^ (((sb >> 9) & 1) << 5); R = (st >> 1) * 16 + swz / 64; C = (st & 1) * 32 + (swz % 64) / 2; }
DI int perm32(int rho) { const int n = rho >> 4, i = rho & 15; return 8 * (i >> 2) + 4 * n + (i & 3); }
struct Unit { int pm, pn; };
struct Gemm { const bf16_t* A; const bf16_t* Bt; int M, N, K; };
struct StaticOrder {
    int nM, nN, nwg, G, c;
    DI void init(int M, int N, int G_, int c_) { nM = M / BM; nN = N / BM; nwg = nM * nN; G = G_; c = c_; }
    DI bool next(int i, Unit& u) const {
        const long L = (long)i * G + c; if (L >= nwg) return false;
        int wgid = (int)L; { const int q = nwg / NXCD, r = nwg % NXCD, xcd = wgid % NXCD, off = wgid / NXCD; wgid = (xcd < r ? xcd * (q + 1) : r * (q + 1) + (xcd - r) * q) + off; }
        const int nig = WGM * nN, gid = wgid / nig, fm = gid * WGM, gsz = (nM - fm) < WGM ? (nM - fm) : WGM;
        u.pm = fm + ((wgid % nig) % gsz); u.pn = (wgid % nig) / gsz; return true;
    }
};
DI unsigned cvt_pk_bf16(float lo, float hi) { unsigned r; asm volatile("v_cvt_pk_bf16_f32 %0, %1, %2" : "=v"(r) : "v"(lo), "v"(hi)); return r; }

DI float rstd_of(const float* ssq, int row) { return ssq ? 1.0f / sqrtf(ssq[row] * (1.f / D) + EPS) : 1.0f; }
struct EpiStore {
    static constexpr bool PERM = true;
    bf16_t* O; int ldc; const float* ssq;
    DI void operator()(const f32x4 (&acc)[2][2][4][2], const Unit& u, int wr, int wc, int fr, int fq) const {
        const int row0 = u.pm * BM + wr * 64 + fr, col0 = u.pn * BM + wc * 32 + 8 * fq;
        float rsv[2][4];
#pragma unroll
        for (int ai = 0; ai < 2; ++ai)
#pragma unroll
            for (int m = 0; m < 4; ++m) rsv[ai][m] = ssq ? ssq[row0 + ai * HALF + m * 16] : 0.f;
#pragma unroll
        for (int ai = 0; ai < 2; ++ai)
#pragma unroll
            for (int m = 0; m < 4; ++m) { bf16_t* rowp = O + (size_t)(row0 + ai * HALF + m * 16) * ldc + col0; const float rs = ssq ? 1.0f / sqrtf(rsv[ai][m] * (1.f / D) + EPS) : 1.0f;
#pragma unroll
                for (int bj = 0; bj < 2; ++bj) { const f32x4 v0 = acc[ai][bj][m][0] * rs, v1 = acc[ai][bj][m][1] * rs;
                    u32x4 w; w.x = cvt_pk_bf16(v0[0], v0[1]); w.y = cvt_pk_bf16(v0[2], v0[3]); w.z = cvt_pk_bf16(v1[0], v1[1]); w.w = cvt_pk_bf16(v1[2], v1[3]);
                    *(u32x4*)(rowp + bj * HALF) = w; } }
    }
};
struct EpiStoreKV {
    static constexpr bool PERM = true;
    bf16_t* O; bf16_t* VT_;
    DI void operator()(const f32x4 (&acc)[2][2][4][2], const Unit& u, int wr, int wc, int fr, int fq) const {
        const int row0 = u.pm * BM + wr * 64 + fr, col0 = u.pn * BM + wc * 32 + 8 * fq;
#pragma unroll
        for (int ai = 0; ai < 2; ++ai)
#pragma unroll
            for (int m = 0; m < 4; ++m) { const int row = row0 + ai * HALF + m * 16;
#pragma unroll
                for (int bj = 0; bj < 2; ++bj) { const f32x4 v0 = acc[ai][bj][m][0], v1 = acc[ai][bj][m][1]; const int col = col0 + bj * HALF;
                    if (u.pn == 0) { u32x4 w; w.x = cvt_pk_bf16(v0[0], v0[1]); w.y = cvt_pk_bf16(v0[2], v0[3]); w.z = cvt_pk_bf16(v1[0], v1[1]); w.w = cvt_pk_bf16(v1[2], v1[3]);
                        *(u32x4*)(O + (size_t)row * 512 + col) = w; }
                    else { bf16_t* vp = VT_ + ((size_t)(row >> 8) * 256 + (col - 256)) * 256 + (row & 255);
#pragma unroll
                        for (int j = 0; j < 4; ++j) { vp[(size_t)j * 256] = f2bf(v0[j]); vp[(size_t)(4 + j) * 256] = f2bf(v1[j]); } } } }
    }
};
DI float silu_mul(float g, float u) { const float e = __builtin_amdgcn_exp2f(-g * LOG2E); return g * __builtin_amdgcn_rcpf(1.0f + e) * u; }
struct EpiSwiglu {
    static constexpr bool PERM = true;
    bf16_t* O; const float* ssq;
    DI void operator()(const f32x4 (&acc)[2][2][4][2], const Unit& u, int wr, int wc, int fr, int fq) const {
        const int row0 = u.pm * BM + wr * 64 + fr, col0 = u.pn * 128 + wc * 16 + 4 * fq;
        float rsv[2][4];
#pragma unroll
        for (int ai = 0; ai < 2; ++ai)
#pragma unroll
            for (int m = 0; m < 4; ++m) rsv[ai][m] = ssq[row0 + ai * HALF + m * 16];
#pragma unroll
        for (int ai = 0; ai < 2; ++ai)
#pragma unroll
            for (int m = 0; m < 4; ++m) { bf16_t* rowp = O + (size_t)(row0 + ai * HALF + m * 16) * FF + col0; const float rs = 1.0f / sqrtf(rsv[ai][m] * (1.f / D) + EPS);
#pragma unroll
                for (int bj = 0; bj < 2; ++bj) { const f32x4 g = acc[ai][bj][m][0] * rs, up = acc[ai][bj][m][1] * rs;
                    u32x2 w; w.x = cvt_pk_bf16(silu_mul(g[0], up[0]), silu_mul(g[1], up[1])); w.y = cvt_pk_bf16(silu_mul(g[2], up[2]), silu_mul(g[3], up[3]));
                    *(u32x2*)(rowp + bj * 64) = w; } }
    }
};
struct EpiResid {
    static constexpr bool PERM = true;
    const float* xin; float* xout; float scale; bf16_t* xb; float* ssq;
    DI void operator()(const f32x4 (&acc)[2][2][4][2], const Unit& u, int wr, int wc, int fr, int fq) const {
        const int row0 = u.pm * BM + wr * 64 + fr, col0 = u.pn * BM + wc * 32 + 8 * fq;
#pragma unroll
        for (int ai = 0; ai < 2; ++ai) {
            f32x4 xv[4][2][2];
#pragma unroll
            for (int m = 0; m < 4; ++m)
#pragma unroll
                for (int bj = 0; bj < 2; ++bj) { const size_t o = (size_t)(row0 + ai * HALF + m * 16) * D + col0 + bj * HALF; xv[m][bj][0] = *(const f32x4*)(xin + o); xv[m][bj][1] = *(const f32x4*)(xin + o + 4); }
#pragma unroll
            for (int m = 0; m < 4; ++m) { const int row = row0 + ai * HALF + m * 16; const size_t off = (size_t)row * D + col0; float sq = 0.f;
#pragma unroll
                for (int bj = 0; bj < 2; ++bj) { const size_t o = off + bj * HALF;
                    const f32x4 x0 = xv[m][bj][0] + acc[ai][bj][m][0] * scale, x1 = xv[m][bj][1] + acc[ai][bj][m][1] * scale;
                    *(f32x4*)(xout + o) = x0; *(f32x4*)(xout + o + 4) = x1;
                    sq += (x0[0] * x0[0] + x0[1] * x0[1]) + (x0[2] * x0[2] + x0[3] * x0[3]) + (x1[0] * x1[0] + x1[1] * x1[1]) + (x1[2] * x1[2] + x1[3] * x1[3]);
                    if (xb) { u32x4 w; w.x = pk2(x0[0], x0[1]); w.y = pk2(x0[2], x0[3]); w.z = pk2(x1[0], x1[1]); w.w = pk2(x1[2], x1[3]); *(u32x4*)(xb + o) = w; } }
                if (ssq) { sq += __shfl_xor(sq, 16); sq += __shfl_xor(sq, 32); if (fq == 0) atomicAdd(ssq + row, sq); } }
        }
    }
};

template <class Epi, class Sched>
DI void gemm_phase(LAS unsigned char* lds, const Gemm g, const Sched& S, const Epi& E, const int tid) {
    const int wid = __builtin_amdgcn_readfirstlane(tid >> 6), lane = tid & 63, wr = wid >> 2, wc = wid & 3, fr = lane & 15, fq = lane >> 4;
    const int K = g.K, nt = K / BK;
    unsigned voffA[2], voffB[2];
#pragma unroll
    for (int i = 0; i < 2; ++i) { int R, C; stage_rc(tid * 16 + i * 8192, R, C); const int Rb = Epi::PERM ? ((R & ~31) + perm32(R & 31)) : R;
        voffA[i] = (unsigned)(R * K + C) * 2u; voffB[i] = (unsigned)(Rb * K + C) * 2u; }
    const size_t kstep = (size_t)(BK * 2);
    const size_t hstep = (size_t)HALF * K * 2;
    const size_t tstep = 2 * hstep;
    const unsigned ldsw = (unsigned)wid * 1024u;
    const int aoff = lds_byte(wr * 64 + fr, fq * 8), boff = lds_byte(wc * 32 + fr, fq * 8);
#define PG8_SA(b, h) (((b) * 2 + (h)) * HTB)
#define PG8_SB(b, h) ((4 + (b) * 2 + (h)) * HTB)
#define PG8_STAGE(bufoff, gbase, voff) do { _Pragma("unroll") for (int _i = 0; _i < 2; ++_i) \
        __builtin_amdgcn_global_load_lds((const unsigned*)((const char*)(gbase) + (voff)[_i]), (LAS unsigned*)(lds + (bufoff) + ldsw + _i * 8192), 16, 0, 0); } while (0)
#define PG8_LDA(dst, b, h) do { _Pragma("unroll") for (int m = 0; m < 4; ++m) _Pragma("unroll") for (int k = 0; k < 2; ++k) dst[m][k] = *(const LAS bf16x8*)(lds + PG8_SA(b, h) + aoff + m * 2048 + k * 1024); } while (0)
#define PG8_LDB(dst, b, h) do { _Pragma("unroll") for (int n = 0; n < 2; ++n) _Pragma("unroll") for (int k = 0; k < 2; ++k) dst[n][k] = *(const LAS bf16x8*)(lds + PG8_SB(b, h) + boff + n * 2048 + k * 1024); } while (0)
#define PG8_MMA(ai, bj, At, Bt) do { __builtin_amdgcn_s_setprio(1); _Pragma("unroll") for (int m = 0; m < 4; ++m) _Pragma("unroll") for (int n = 0; n < 2; ++n) _Pragma("unroll") for (int k = 0; k < 2; ++k) \
        acc[ai][bj][m][n] = __builtin_amdgcn_mfma_f32_16x16x32_bf16(Bt[n][k], At[m][k], acc[ai][bj][m][n], 0, 0, 0); __builtin_amdgcn_s_setprio(0); } while (0)
#define PG8_WAIT_V(n) asm volatile("s_waitcnt vmcnt(" #n ")" ::: "memory")
#define PG8_WAIT_L(n) asm volatile("s_waitcnt lgkmcnt(" #n ")" ::: "memory")
#define PG8_BAR __builtin_amdgcn_s_barrier()
#define PG8_SCHED __builtin_amdgcn_sched_barrier(0)
    Unit cur, nxt; int ui = 0;
    if (!S.next(0, cur)) return;
    f32x4 acc[2][2][4][2];
#pragma unroll
    for (int a = 0; a < 2; ++a)
#pragma unroll
        for (int b = 0; b < 2; ++b)
#pragma unroll
            for (int m = 0; m < 4; ++m)
#pragma unroll
                for (int n = 0; n < 2; ++n) acc[a][b][m][n] = (f32x4){0.f, 0.f, 0.f, 0.f};
    bf16x8 At[4][2], B0[2][2], B1[2][2];
    const char* cA = (const char*)g.A + (size_t)cur.pm * tstep; const char* cB = (const char*)g.Bt + (size_t)cur.pn * tstep;
    PG8_STAGE(PG8_SB(0, 0), cB, voffB); PG8_STAGE(PG8_SB(0, 1), cB + hstep, voffB); PG8_STAGE(PG8_SA(0, 0), cA, voffA); PG8_STAGE(PG8_SA(0, 1), cA + hstep, voffA);
    if (wr == 1) PG8_BAR;
    PG8_WAIT_V(2); PG8_BAR;
    PG8_STAGE(PG8_SB(1, 0), cB + kstep, voffB); PG8_STAGE(PG8_SA(1, 0), cA + kstep, voffA); PG8_STAGE(PG8_SB(1, 1), cB + hstep + kstep, voffB);
    PG8_WAIT_V(6); PG8_BAR;
    for (;;) {
        const bool has_next = S.next(ui + 1, nxt);
        const char* nA = has_next ? (const char*)g.A + (size_t)nxt.pm * tstep : cA; const char* nB = has_next ? (const char*)g.Bt + (size_t)nxt.pn * tstep : cB;
        for (int t = 0; t < nt; t += 2) {
            const bool last = (t == nt - 2);
            const char* a1 = cA + (size_t)(t + 1) * kstep;
            const char* a2 = last ? nA : cA + (size_t)(t + 2) * kstep; const char* b2 = last ? nB : cB + (size_t)(t + 2) * kstep;
            const char* a3 = a2 + kstep; const char* b3 = b2 + kstep;
            PG8_LDB(B0, 0, 0); PG8_LDB(B1, 0, 1); PG8_SCHED; PG8_LDA(At, 0, 0); PG8_STAGE(PG8_SA(1, 1), a1 + hstep, voffA);
            PG8_WAIT_V(8); PG8_WAIT_L(0); PG8_BAR; PG8_MMA(0, 0, At, B0); PG8_MMA(0, 1, At, B1); PG8_BAR; PG8_SCHED;
            PG8_LDA(At, 0, 1); PG8_STAGE(PG8_SB(0, 0), b2, voffB); PG8_STAGE(PG8_SB(0, 1), b2 + hstep, voffB); PG8_STAGE(PG8_SA(0, 0), a2, voffA);
            PG8_WAIT_V(8); PG8_WAIT_L(0); PG8_BAR; PG8_MMA(1, 0, At, B0); PG8_MMA(1, 1, At, B1); PG8_BAR; PG8_SCHED;
            PG8_LDB(B0, 1, 0); PG8_LDB(B1, 1, 1); PG8_SCHED; PG8_LDA(At, 1, 0); PG8_STAGE(PG8_SA(0, 1), a2 + hstep, voffA);
            PG8_WAIT_V(8); PG8_WAIT_L(0); PG8_BAR; PG8_MMA(0, 0, At, B0); PG8_MMA(0, 1, At, B1); PG8_BAR; PG8_SCHED;
            PG8_LDA(At, 1, 1); PG8_STAGE(PG8_SB(1, 0), b3, voffB); PG8_STAGE(PG8_SB(1, 1), b3 + hstep, voffB); PG8_STAGE(PG8_SA(1, 0), a3, voffA);
            PG8_WAIT_V(8); PG8_WAIT_L(0); PG8_BAR; PG8_MMA(1, 0, At, B0); PG8_MMA(1, 1, At, B1); PG8_BAR; PG8_SCHED;
        }
        if (wr == 0) PG8_BAR;
        E(acc, cur, wr, wc, fr, fq);
        if (!has_next) break;
#pragma unroll
        for (int a = 0; a < 2; ++a)
#pragma unroll
            for (int b = 0; b < 2; ++b)
#pragma unroll
                for (int m = 0; m < 4; ++m)
#pragma unroll
                    for (int n = 0; n < 2; ++n) acc[a][b][m][n] = (f32x4){0.f, 0.f, 0.f, 0.f};
        cur = nxt; cA = nA; cB = nB; ++ui;
        if (wr == 1) PG8_BAR;
    }
    PG8_WAIT_V(0);
    PG8_BAR;
#undef PG8_SA
#undef PG8_SB
#undef PG8_STAGE
#undef PG8_LDA
#undef PG8_LDB
#undef PG8_MMA
#undef PG8_WAIT_V
#undef PG8_WAIT_L
#undef PG8_BAR
#undef PG8_SCHED
}
}

DI void grid_barrier(unsigned* bar, unsigned G, unsigned& gen) {
    __syncthreads();
    if (threadIdx.x == 0) {
        ++gen;
        __builtin_amdgcn_fence(__ATOMIC_RELEASE, "agent");
        const unsigned prev = __hip_atomic_fetch_add(bar, 1u, __ATOMIC_RELAXED, __HIP_MEMORY_SCOPE_AGENT);
        if (prev == G * gen - 1u) __hip_atomic_store(bar + 64, gen, __ATOMIC_RELAXED, __HIP_MEMORY_SCOPE_AGENT);
        else while (__hip_atomic_load(bar + 64, __ATOMIC_RELAXED, __HIP_MEMORY_SCOPE_AGENT) < gen) __builtin_amdgcn_s_sleep(1);
        __builtin_amdgcn_fence(__ATOMIC_ACQUIRE, "agent");
    }
    __syncthreads();
}

struct Params { const float* in[25]; float* out; unsigned char* ws; int lo, hi; };
typedef const __attribute__((address_space(4))) Params CParams;

struct Ctx {
    CParams* p; int l; int tid, lane, wave, gw, ngw, G, bid;
    LAS unsigned char* lds;
};

DI void transpose_item(const float* W, int K, int N, bf16_t* WT, int sh, int add, LAS float* scr, int item, int lane, const float* gain = nullptr) {
    const int nblk = N / 32, kb = item / nblk, nb = item % nblk, k0 = 64 * kb, n0 = 32 * nb;
    f32x4 wv[8];
#pragma unroll
    for (int i = 0; i < 8; ++i) { const int kk = (lane >> 3) + 8 * i; wv[i] = *(const f32x4*)(W + (size_t)(k0 + kk) * N + n0 + 4 * (lane & 7)); }
#pragma unroll
    for (int i = 0; i < 8; ++i) { const int kk = (lane >> 3) + 8 * i; const float gk = gain ? gain[k0 + kk] : 1.0f; LAS float* d = scr + kk * 33 + 4 * (lane & 7);
        d[0] = wv[i].x * gk; d[1] = wv[i].y * gk; d[2] = wv[i].z * gk; d[3] = wv[i].w * gk; }
    asm volatile("s_waitcnt lgkmcnt(0)" ::: "memory");
    const int c = lane & 7;
#pragma unroll
    for (int j = 0; j < 4; ++j) { const int n = (lane >> 3) + 8 * j; const LAS float* s = scr + (8 * c) * 33 + n;
        u32x4 o; o.x = pk2(s[0 * 33], s[1 * 33]); o.y = pk2(s[2 * 33], s[3 * 33]); o.z = pk2(s[4 * 33], s[5 * 33]); o.w = pk2(s[6 * 33], s[7 * 33]);
        const int nn = n0 + n; const int row = ((nn >> 2) << sh) + (nn & 3) + add;
        *(u32x4*)(WT + (size_t)row * K + k0 + 8 * c) = o; }
    asm volatile("s_waitcnt lgkmcnt(0)" ::: "memory");
}

DI void norm_row_bf16(const float* xrow, const float* g, bf16_t* orow, int lane) {
    const f32x4* xr = (const f32x4*)xrow + lane; const f32x4* gr = (const f32x4*)g + lane;
    f32x4 v[4]; float s = 0.f;
#pragma unroll
    for (int j = 0; j < 4; ++j) { v[j] = xr[64 * j]; s += (v[j].x * v[j].x + v[j].y * v[j].y) + (v[j].z * v[j].z + v[j].w * v[j].w); }
    const float rstd = 1.0f / sqrtf(wave_sum(s) * (1.f / D) + EPS);
    u32x2* o8 = (u32x2*)orow + lane;
#pragma unroll
    for (int j = 0; j < 4; ++j) { const f32x4 gv = gr[64 * j]; u32x2 w; w.x = pk2(v[j].x * rstd * gv.x, v[j].y * rstd * gv.y); w.y = pk2(v[j].z * rstd * gv.z, v[j].w * rstd * gv.w); o8[64 * j] = w; }
}
DI void norm_row_f32(const float* xrow, const float* g, float* orow, int lane) {
    const f32x4* xr = (const f32x4*)xrow + lane; const f32x4* gr = (const f32x4*)g + lane;
    f32x4 v[4]; float s = 0.f;
#pragma unroll
    for (int j = 0; j < 4; ++j) { v[j] = xr[64 * j]; s += (v[j].x * v[j].x + v[j].y * v[j].y) + (v[j].z * v[j].z + v[j].w * v[j].w); }
    const float rstd = 1.0f / sqrtf(wave_sum(s) * (1.f / D) + EPS);
    f32x4* o = (f32x4*)orow + lane;
#pragma unroll
    for (int j = 0; j < 4; ++j) { const f32x4 gv = gr[64 * j]; o[64 * j] = v[j] * rstd * gv; }
}
DI void norm_phase(const Ctx& c, const float* x, const float* g, bf16_t* H, int rows) {
    for (int m = c.gw; m < rows; m += c.ngw) norm_row_bf16(x + (size_t)m * D, g, H + (size_t)m * D, c.lane);
}

DI void vt_load(bf16x8 (&v)[8], const bf16_t* src  , int pitch, int lane) {
    const int c8 = (lane & 7) * 8, tr = lane >> 3;
#pragma unroll
    for (int i = 0; i < 8; ++i) v[i] = *(const bf16x8*)(src + (size_t)(tr + 8 * i) * pitch + c8);
}
DI void vt_item(const bf16x8 (&v)[8], bf16_t* dst  , int dst_ld, int t0, int dsh, int L, LAS bf16_t* tile, int lane) {
    const int c8 = (lane & 7) * 8, tr = lane >> 3, d1 = (1 << dsh) - 1;
#pragma unroll
    for (int i = 0; i < 8; ++i) { const int t = tr + 8 * i; const int cp = ((t & d1) << (6 - dsh)) + (t >> dsh);
#pragma unroll
        for (int j = 0; j < 8; ++j) tile[(c8 + j) * 72 + cp] = (bf16_t)v[i][j]; }
    asm volatile("s_waitcnt lgkmcnt(0)" ::: "memory");
    const int seglen = 64 >> dsh;
#pragma unroll
    for (int i = 0; i < 8; ++i) { const int dim = tr + 8 * i; const bf16x8 w = *(const LAS bf16x8*)(tile + dim * 72 + c8);
        bf16_t* drow = dst + (size_t)dim * dst_ld + (t0 >> dsh);
        if (dsh < 4) { const int rr = c8 / seglen, off = c8 % seglen; *(bf16x8*)(drow + (size_t)rr * L + off) = w; }
        else { const int rr = c8 >> 2; *(s16x4*)(drow + (size_t)rr * L) = __builtin_shufflevector(w, w, 0, 1, 2, 3); *(s16x4*)(drow + (size_t)(rr + 1) * L) = __builtin_shufflevector(w, w, 4, 5, 6, 7); } }
    asm volatile("s_waitcnt lgkmcnt(0)" ::: "memory");
}

#define MFMA32(a, b, c) __builtin_amdgcn_mfma_f32_32x32x16_bf16((a), (b), (c), 0, 0, 0)
DI int crow(int i, int h) { return (i & 3) + 8 * (i >> 2) + 4 * h; }
DI f32x16 zero16() { f32x16 z;
#pragma unroll
    for (int i = 0; i < 16; ++i) z[i] = 0.f; return z; }
DI void load_kf(bf16x8 (&kf)[4], const bf16_t* krow) {
#pragma unroll
    for (int s = 0; s < 4; ++s) kf[s] = *(const bf16x8*)(krow + 16 * s);
}
DI f32x16 qk4(const bf16x8 (&kf)[4], const bf16x8 (&qf)[4]) {
    f32x16 st = zero16();
#pragma unroll
    for (int s = 0; s < 4; ++s) st = MFMA32(kf[s], qf[s], st);
    return st;
}
DI f32x16 qk2(const bf16x8& k0, const bf16x8& k1, const bf16x8& q0, const bf16x8& q1) { f32x16 st = zero16(); st = MFMA32(k0, q0, st); st = MFMA32(k1, q1, st); return st; }
DI void load_vf(bf16x8 (&vf)[2][2], const bf16_t* vt, int LD) {
#pragma unroll
    for (int db = 0; db < 2; ++db)
#pragma unroll
        for (int s = 0; s < 2; ++s) { const bf16_t* p = vt + (size_t)db * 32 * LD + 16 * s; const s16x4 a = *(const s16x4*)p; const s16x4 b = *(const s16x4*)(p + 8);
            vf[db][s] = __builtin_shufflevector(a, b, 0, 1, 2, 3, 4, 5, 6, 7); }
}
DI void apply_mask(f32x16& st, int kidx0, int lo, int hi, int h) {
#pragma unroll
    for (int i = 0; i < 16; ++i) { const int kid = kidx0 + crow(i, h); st[i] = (kid >= lo && kid <= hi) ? st[i] : -1e30f; }
}
DI void softmax_pv(f32x16 st, float& m, float& l, f32x16& oa, f32x16& ob, float c, const bf16x8 (&vf)[2][2], float bias = 0.f) {
    float mx = fmaxf(fmaxf(fmaxf(st[0], st[1]), fmaxf(st[2], st[3])), fmaxf(fmaxf(st[4], st[5]), fmaxf(st[6], st[7])));
    mx = fmaxf(mx, fmaxf(fmaxf(fmaxf(st[8], st[9]), fmaxf(st[10], st[11])), fmaxf(fmaxf(st[12], st[13]), fmaxf(st[14], st[15]))));
    mx = fmaxf(mx, __shfl_xor(mx, 32));
    const float mnew = fmaxf(m, mx * c + bias);
    if (__ballot(mnew > m) != 0ull) {
        const float alpha = __builtin_amdgcn_exp2f(m - mnew);
        m = mnew; l *= alpha;
#pragma unroll
        for (int i = 0; i < 16; ++i) { oa[i] *= alpha; ob[i] *= alpha; }
    }
    float rs = 0.f;
    const float nmb = bias - m;
#pragma unroll
    for (int i = 0; i < 16; ++i) { const float p = __builtin_amdgcn_exp2f(__builtin_fmaf(st[i], c, nmb)); st[i] = p; rs += p; }
    rs += __shfl_xor(rs, 32);
    l += rs;
#pragma unroll
    for (int s = 0; s < 2; ++s) {
        u32x4 pw; pw.x = pk2(st[8 * s], st[8 * s + 1]); pw.y = pk2(st[8 * s + 2], st[8 * s + 3]); pw.z = pk2(st[8 * s + 4], st[8 * s + 5]); pw.w = pk2(st[8 * s + 6], st[8 * s + 7]);
        const bf16x8 pb = __builtin_bit_cast(bf16x8, pw);
        oa = MFMA32(vf[0][s], pb, oa); ob = MFMA32(vf[1][s], pb, ob);
    }
}
DI void lds_kf(bf16x8 (&kf)[4], const LAS bf16_t* Kt, int sb, int r, int h) {
#pragma unroll
    for (int s = 0; s < 4; ++s) kf[s] = *(const LAS bf16x8*)(Kt + (32 * sb + r) * 72 + 16 * s + 8 * h);
}
DI void lds_vf(bf16x8 (&vf)[2][2], const LAS bf16_t* Vt, int sb, int r, int h) {
#pragma unroll
    for (int db = 0; db < 2; ++db)
#pragma unroll
        for (int s = 0; s < 2; ++s) { const LAS bf16_t* p = Vt + (32 * db + r) * 72 + 32 * sb + 16 * s + 4 * h; const s16x4 a = *(const LAS s16x4*)p; const s16x4 b = *(const LAS s16x4*)(p + 8);
            vf[db][s] = __builtin_shufflevector(a, b, 0, 1, 2, 3, 4, 5, 6, 7); }
}
#define ATT_BAR() do { asm volatile("s_waitcnt lgkmcnt(0)" ::: "memory"); __builtin_amdgcn_s_barrier(); asm volatile("" ::: "memory"); } while (0)
constexpr int ATT_TILE = 64 * 72;
constexpr int ATT_BUF = 2 * ATT_TILE;
constexpr int ATT_FLAGS = 8 * ATT_TILE * 2;
DI void store_o(bf16_t* orow, const f32x16& oa, const f32x16& ob, float sc, int h) {
#pragma unroll
    for (int g4 = 0; g4 < 4; ++g4) {
        u32x2 w; w.x = pk2(oa[4 * g4] * sc, oa[4 * g4 + 1] * sc); w.y = pk2(oa[4 * g4 + 2] * sc, oa[4 * g4 + 3] * sc);
        *(u32x2*)(orow + 8 * g4 + 4 * h) = w;
        u32x2 w2; w2.x = pk2(ob[4 * g4] * sc, ob[4 * g4 + 1] * sc); w2.y = pk2(ob[4 * g4 + 2] * sc, ob[4 * g4 + 3] * sc);
        *(u32x2*)(orow + 32 + 8 * g4 + 4 * h) = w2;
    }
}
DI void store_o_rows(bf16_t* orow, size_t rstride, const f32x16& oa, const f32x16& ob, float sc, int lane, LAS bf16_t* stg) {
    const int r = lane & 31, h = lane >> 5;
    bf16_t* row0 = orow - (size_t)r * rstride;
#pragma unroll
    for (int g4 = 0; g4 < 4; ++g4) {
        u32x2 w; w.x = pk2(oa[4 * g4] * sc, oa[4 * g4 + 1] * sc); w.y = pk2(oa[4 * g4 + 2] * sc, oa[4 * g4 + 3] * sc);
        *(LAS u32x2*)(stg + r * 72 + 8 * g4 + 4 * h) = w;
        u32x2 w2; w2.x = pk2(ob[4 * g4] * sc, ob[4 * g4 + 1] * sc); w2.y = pk2(ob[4 * g4 + 2] * sc, ob[4 * g4 + 3] * sc);
        *(LAS u32x2*)(stg + r * 72 + 32 + 8 * g4 + 4 * h) = w2;
    }
    asm volatile("s_waitcnt lgkmcnt(0)" ::: "memory");
#pragma unroll
    for (int i = 0; i < 4; ++i) { const int row = (lane >> 3) + 8 * i; const bf16x8 v = *(const LAS bf16x8*)(stg + row * 72 + (lane & 7) * 8);
        *(bf16x8*)(row0 + (size_t)row * rstride + (lane & 7) * 8) = v; }
    asm volatile("s_waitcnt lgkmcnt(0)" ::: "memory");
}
#define O_STG(c) ((LAS bf16_t*)((c).lds + 81920 + (c).wave * 4608))
constexpr int BIGI = 1 << 29;

DI void attn_A_unit(const Ctx& c, int b, int hd, int u, float lam, float lam_init, const float* subln) {
    const int lane = c.lane, r = lane & 31, h = lane >> 5, w = c.wave, qt = 8 * u + w;
    const bf16_t* QKV = (const bf16_t*)(c.p->ws + WS_BIG);
    const size_t tok_q = (size_t)b * SEQ + qt * 32 + r;
    const bf16_t* qrow = QKV + tok_q * NQKV + COL_QA + hd * 64 + 8 * h;
    bf16x8 qf[4];
#pragma unroll
    for (int s = 0; s < 4; ++s) qf[s] = *(const bf16x8*)(qrow + 16 * s);
    const int trow = c.tid >> 3, tch = (c.tid & 7) * 8;
    const bf16_t* kg = QKV + ((size_t)b * SEQ + trow) * NQKV + COL_KA + hd * 64 + tch;
    const bf16_t* vg = (const bf16_t*)(c.p->ws + WS_VT) + ((size_t)(hd * 16 + b) * 64 + trow) * SEQ + tch;
    LAS bf16_t* L = (LAS bf16_t*)c.lds;
    const int loff = trow * 72 + tch;
    float m1 = -1e30f, l1 = 0.f, m2 = -1e30f, l2 = 0.f;
    f32x16 o1a = zero16(), o1b = zero16(), o2a = zero16(), o2b = zero16();
    const float sc = 0.17677669529663687f * LOG2E;
    const int qidx = qt * 32 + r, nt = 4 * u + 4;
    bf16x8 kr = *(const bf16x8*)kg, vr = *(const bf16x8*)vg;
    *(LAS bf16x8*)(L + loff) = kr; *(LAS bf16x8*)(L + ATT_TILE + loff) = vr;
    __syncthreads();
    for (int t = 0; t < nt; ++t) {
        if (t + 1 < nt) { kr = *(const bf16x8*)(kg + (size_t)(t + 1) * 64 * NQKV); vr = *(const bf16x8*)(vg + (t + 1) * 64); }
        const LAS bf16_t* Kt = L + (t & 1) * ATT_BUF; const LAS bf16_t* Vt = Kt + ATT_TILE;
#pragma unroll
        for (int sb = 0; sb < 2; ++sb) {
            const int kb = 2 * t + sb;
            if (kb <= qt) {
                bf16x8 kf[4], vf[2][2]; lds_kf(kf, Kt, sb, r, h); lds_vf(vf, Vt, sb, r, h);
                f32x16 st1 = qk2(kf[0], kf[1], qf[0], qf[1]);
                f32x16 st2 = qk2(kf[2], kf[3], qf[2], qf[3]);
                if (kb == qt) { apply_mask(st1, kb * 32, -BIGI, qidx, h); apply_mask(st2, kb * 32, -BIGI, qidx, h); }
                softmax_pv(st1, m1, l1, o1a, o1b, sc, vf);
                softmax_pv(st2, m2, l2, o2a, o2b, sc, vf);
            }
        }
        if (t + 1 < nt) { LAS bf16_t* Ln = L + ((t + 1) & 1) * ATT_BUF; *(LAS bf16x8*)(Ln + loff) = kr; *(LAS bf16x8*)(Ln + ATT_TILE + loff) = vr; }
        __syncthreads();
    }
    const float i1 = 1.0f / l1, i2 = lam / l2;
    float ss = 0.f;
#pragma unroll
    for (int i = 0; i < 16; ++i) { o1a[i] = o1a[i] * i1 - o2a[i] * i2; o1b[i] = o1b[i] * i1 - o2b[i] * i2; ss += o1a[i] * o1a[i] + o1b[i] * o1b[i]; }
    ss += __shfl_xor(ss, 32);
    const float rn = (1.0f / sqrtf(ss * (1.f / 64.f) + EPS)) * (1.0f - lam_init);
#pragma unroll
    for (int i = 0; i < 16; ++i) { const int dm = crow(i, h); o1a[i] *= subln[dm]; o1b[i] *= subln[32 + dm]; }
    bf16_t* orow = (bf16_t*)(c.p->ws + WS_MIXED) + tok_q * D + hd * 64;
    store_o_rows(orow, D, o1a, o1b, rn, lane, O_STG(c));
}

DI void attn_B_item(const Ctx& c, int br, int b, int hd, int tile) {
    const int lane = c.lane, r = lane & 31, h = lane >> 5;
    const int dsh = 2 * br, d = 1 << dsh, L = SEQ >> dsh, tpr = L >> 5;
    const int rr = tile / tpr, mt = tile % tpr, m0 = mt * 32, mq = m0 + r;
    const bf16_t* QKV = (const bf16_t*)(c.p->ws + WS_BIG);
    const size_t tok_q = (size_t)b * SEQ + mq * d + rr;
    const bf16_t* qrow = QKV + tok_q * NQKV + COL_QB + hd * 64 + 8 * h;
    bf16x8 qf[4];
#pragma unroll
    for (int s = 0; s < 4; ++s) qf[s] = *(const bf16x8*)(qrow + 16 * s);
    const bf16_t* kbase = QKV + ((size_t)b * SEQ + rr + (size_t)r * d) * NQKV + COL_KB + hd * 64 + 8 * h;
    const bf16_t* vt = (const bf16_t*)(c.p->ws + WS_VT) + ((size_t)((10 + hd * 3 + br) * 16 + b) * 64 + r) * SEQ + rr * L + 4 * h;
    float m = -1e30f, l = 0.f; f32x16 oa = zero16(), ob = zero16();
    const float sc = 0.125f * LOG2E;
    int kstart = m0 - 128; if (kstart < 0) kstart = 0;
    bf16x8 kf[4]; load_kf(kf, kbase + (size_t)kstart * d * NQKV);
    bf16x8 vf[2][2]; load_vf(vf, vt + kstart, SEQ);
    for (int kidx0 = kstart; kidx0 <= m0; kidx0 += 32) {
        const int knext = kidx0 < m0 ? kidx0 + 32 : kidx0;
        bf16x8 kn[4]; load_kf(kn, kbase + (size_t)knext * d * NQKV);
        bf16x8 vn[2][2]; load_vf(vn, vt + knext, SEQ);
        f32x16 st = qk4(kf, qf);
        if (kidx0 < m0 - 97 || kidx0 > m0 - 31) apply_mask(st, kidx0, mq - 128, mq, h);
        softmax_pv(st, m, l, oa, ob, sc, vf);
#pragma unroll
        for (int s = 0; s < 4; ++s) kf[s] = kn[s];
#pragma unroll
        for (int a = 0; a < 2; ++a)
#pragma unroll
            for (int s = 0; s < 2; ++s) vf[a][s] = vn[a][s];
    }
    bf16_t* orow = (bf16_t*)(c.p->ws + WS_H) + ((size_t)br * MTOK + tok_q) * 384 + hd * 64;
    store_o(orow, oa, ob, 1.0f / l, h);
    if (h == 0) ((float*)(c.p->ws + WS_LSE))[((size_t)br * MTOK + tok_q) * 6 + hd] = m + __builtin_amdgcn_logf(l);
}

DI void attn_B_unit(const Ctx& c, int br, int b, int hd, int rr, int U) {
    const int lane = c.lane, r = lane & 31, h = lane >> 5, w = c.wave;
    const int dsh = 2 * br, d = 1 << dsh, L = SEQ >> dsh;
    const int mt = 8 * U + w, m0 = 32 * mt, mq = m0 + r;
    const bf16_t* QKV = (const bf16_t*)(c.p->ws + WS_BIG);
    const size_t tok_q = (size_t)b * SEQ + mq * d + rr;
    const bf16_t* qrow = QKV + tok_q * NQKV + COL_QB + hd * 64 + 8 * h;
    bf16x8 qf[4];
#pragma unroll
    for (int s = 0; s < 4; ++s) qf[s] = *(const bf16x8*)(qrow + 16 * s);
    const int trow = c.tid >> 3, tch = (c.tid & 7) * 8;
    const bf16_t* kg = QKV + ((size_t)b * SEQ + rr + (size_t)trow * d) * NQKV + COL_KB + hd * 64 + tch;
    const bf16_t* vg = (const bf16_t*)(c.p->ws + WS_VT) + ((size_t)((10 + hd * 3 + br) * 16 + b) * 64 + trow) * SEQ + rr * L + tch;
    LAS bf16_t* Lb = (LAS bf16_t*)c.lds;
    const int loff = trow * 72 + tch;
    const float sc = 0.125f * LOG2E;
    const int T0 = (4 * U - 2) < 0 ? 0 : (4 * U - 2), T1 = 4 * U + 3, ntile = T1 - T0 + 1;
    bf16x8 kq[6], vq[6];
#pragma unroll
    for (int j = 0; j < 6; ++j) { const int T = (j < ntile) ? T0 + j : T0; kq[j] = *(const bf16x8*)(kg + (size_t)T * 64 * d * NQKV); vq[j] = *(const bf16x8*)(vg + T * 64); }
    ATT_BAR();
#pragma unroll
    for (int j = 0; j < 6; ++j) { *(LAS bf16x8*)(Lb + j * ATT_BUF + loff) = kq[j]; *(LAS bf16x8*)(Lb + j * ATT_BUF + ATT_TILE + loff) = vq[j]; }
    ATT_BAR();
    float m = -1e30f, l = 0.f; f32x16 oa = zero16(), ob = zero16();
    int kb0 = mt - 4; if (kb0 < 0) kb0 = 0;
    for (int kb = kb0; kb <= mt; ++kb) {
        const LAS bf16_t* Kt = Lb + ((kb >> 1) - T0) * ATT_BUF; const LAS bf16_t* Vt = Kt + ATT_TILE;
        bf16x8 kf[4], vf[2][2]; lds_kf(kf, Kt, kb & 1, r, h); lds_vf(vf, Vt, kb & 1, r, h);
        f32x16 st = qk4(kf, qf);
        if (kb == mt - 4 || kb == mt) apply_mask(st, kb * 32, mq - 128, mq, h);
        softmax_pv(st, m, l, oa, ob, sc, vf);
    }
    ATT_BAR();
    bf16_t* orow = (bf16_t*)(c.p->ws + WS_H) + ((size_t)br * MTOK + tok_q) * 384 + hd * 64;
    store_o_rows(orow, (size_t)d * 384, oa, ob, 1.0f / l, lane, O_STG(c));
    if (h == 0) ((float*)(c.p->ws + WS_LSE))[((size_t)br * MTOK + tok_q) * 6 + hd] = m + __builtin_amdgcn_logf(l);
}

DI void attn_B2_unit(const Ctx& c, int b, int hd, int rp) {
    const int lane = c.lane, r = lane & 31, h = lane >> 5, w = c.wave;
    const int ri = w >> 2, mt = w & 3, rr = 2 * rp + ri, m0 = 32 * mt, mq = m0 + r;
    const bf16_t* QKV = (const bf16_t*)(c.p->ws + WS_BIG);
    const size_t tok_q = (size_t)b * SEQ + mq * 16 + rr;
    const bf16_t* qrow = QKV + tok_q * NQKV + COL_QB + hd * 64 + 8 * h;
    bf16x8 qf[4];
#pragma unroll
    for (int s = 0; s < 4; ++s) qf[s] = *(const bf16x8*)(qrow + 16 * s);
    const int trow = c.tid >> 3, tch = (c.tid & 7) * 8;
    LAS bf16_t* Lb = (LAS bf16_t*)c.lds;
    const int loff = trow * 72 + tch;
    bf16x8 kr[4], vr[4];
#pragma unroll
    for (int i = 0; i < 4; ++i) { const int ri2 = i >> 1, kt = i & 1, rr2 = 2 * rp + ri2;
        kr[i] = *(const bf16x8*)(QKV + ((size_t)b * SEQ + rr2 + (size_t)(64 * kt + trow) * 16) * NQKV + COL_KB + hd * 64 + tch);
        vr[i] = *(const bf16x8*)((const bf16_t*)(c.p->ws + WS_VT) + ((size_t)((10 + hd * 3 + 2) * 16 + b) * 64 + trow) * SEQ + rr2 * 128 + 64 * kt + tch); }
#pragma unroll
    for (int i = 0; i < 4; ++i) { *(LAS bf16x8*)(Lb + (2 * i) * ATT_TILE + loff) = kr[i]; *(LAS bf16x8*)(Lb + (2 * i + 1) * ATT_TILE + loff) = vr[i]; }
    __syncthreads();
    float m = -1e30f, l = 0.f; f32x16 oa = zero16(), ob = zero16();
    const float sc = 0.125f * LOG2E;
    for (int kb = 0; kb <= mt; ++kb) {
        const LAS bf16_t* Kt = Lb + (2 * (ri * 2 + (kb >> 1))) * ATT_TILE; const LAS bf16_t* Vt = Kt + ATT_TILE;
        bf16x8 kf[4], vf[2][2]; lds_kf(kf, Kt, kb & 1, r, h); lds_vf(vf, Vt, kb & 1, r, h);
        f32x16 st = qk4(kf, qf);
        if (kb == mt) apply_mask(st, kb * 32, -BIGI, mq, h);
        softmax_pv(st, m, l, oa, ob, sc, vf);
    }
    __syncthreads();
    bf16_t* orow = (bf16_t*)(c.p->ws + WS_H) + ((size_t)2 * MTOK + tok_q) * 384 + hd * 64;
    store_o_rows(orow, (size_t)16 * 384, oa, ob, 1.0f / l, lane, O_STG(c));
    if (h == 0) ((float*)(c.p->ws + WS_LSE))[((size_t)2 * MTOK + tok_q) * 6 + hd] = m + __builtin_amdgcn_logf(l);
}

DI void attn_C_unit(const Ctx& c, int b, int hd, int qb) {
    const int lane = c.lane, r = lane & 31, h = lane >> 5, w = c.wave, qt = 8 * qb + w;
    const bf16_t* QKV = (const bf16_t*)(c.p->ws + WS_BIG);
    const size_t tok_q = (size_t)b * SEQ + qt * 32 + r;
    const bf16_t* qrow = QKV + tok_q * NQKV + COL_QC + hd * 64 + 8 * h;
    bf16x8 qf[4];
#pragma unroll
    for (int s = 0; s < 4; ++s) qf[s] = *(const bf16x8*)(qrow + 16 * s);
    const float* km = (const float*)(c.p->ws + WS_MISC + 4096) + (size_t)(b * 6 + hd) * 8 * 64 + 8 * h;
    float g[7];
#pragma unroll
    for (int n = 0; n < 7; ++n) {
        float dot = 0.f;
        if (n < qb) {
            float d0 = 0.f, d1 = 0.f, d2 = 0.f, d3 = 0.f;
#pragma unroll
            for (int s = 0; s < 4; ++s) { const f32x4 k0 = *(const f32x4*)(km + n * 64 + 16 * s), k1 = *(const f32x4*)(km + n * 64 + 16 * s + 4);
                d0 += bf2f(qf[s][0]) * k0[0] + bf2f(qf[s][4]) * k1[0]; d1 += bf2f(qf[s][1]) * k0[1] + bf2f(qf[s][5]) * k1[1];
                d2 += bf2f(qf[s][2]) * k0[2] + bf2f(qf[s][6]) * k1[2]; d3 += bf2f(qf[s][3]) * k0[3] + bf2f(qf[s][7]) * k1[3]; }
            dot = (d0 + d1) + (d2 + d3);
        }
        dot += __shfl_xor(dot, 32);
        g[n] = (n < qb) ? dot : -__builtin_inff();
    }
    unsigned selmask = 0, wavemask = 0;
#pragma unroll
    for (int n = 0; n < 7; ++n) {
        int cnt = 0;
#pragma unroll
        for (int n2 = 0; n2 < 7; ++n2) if (n2 != n) cnt += (g[n2] > g[n] || (g[n2] == g[n] && n2 < n)) ? 1 : 0;
        const bool sel = (n < qb && cnt < 3);
        if (sel) selmask |= 1u << n;
        if (__ballot(sel) != 0ull) wavemask |= 1u << n;
    }
    LAS int* flags = (LAS int*)(c.lds + ATT_FLAGS);
    if (lane == 0) flags[w] = (int)wavemask;
    __syncthreads();
    unsigned um = 0;
#pragma unroll
    for (int i = 0; i < 8; ++i) um |= (unsigned)flags[i];
    um = __builtin_amdgcn_readfirstlane(um);
    const int nt = 4 + 4 * __builtin_popcount(um);
    const int trow = c.tid >> 3, tch = (c.tid & 7) * 8;
    const bf16_t* kg = QKV + ((size_t)b * SEQ + trow) * NQKV + COL_KC + hd * 64 + tch;
    const bf16_t* vg = (const bf16_t*)(c.p->ws + WS_VT) + ((size_t)((4 + hd) * 16 + b) * 64 + trow) * SEQ + tch;
    LAS bf16_t* L = (LAS bf16_t*)c.lds;
    const int loff = trow * 72 + tch;
    float m = -1e30f, l = 0.f; f32x16 oa = zero16(), ob = zero16();
    const float sc = 0.125f * LOG2E;
    const int qidx = qt * 32 + r;
    const int np = nt >> 1;
    auto pair_tile = [&](int p) -> int { if (p < 2) return 4 * qb + 2 * p; unsigned rr_ = um; for (int i = (p - 2) >> 1; i > 0; --i) rr_ &= rr_ - 1; return 4 * __builtin_ctz(rr_) + 2 * ((p - 2) & 1); };
    int kt = 4 * qb;
    bf16x8 kr0 = *(const bf16x8*)(kg + (size_t)kt * 64 * NQKV), vr0 = *(const bf16x8*)(vg + kt * 64);
    bf16x8 kr1 = *(const bf16x8*)(kg + (size_t)(kt + 1) * 64 * NQKV), vr1 = *(const bf16x8*)(vg + (kt + 1) * 64);
    *(LAS bf16x8*)(L + loff) = kr0; *(LAS bf16x8*)(L + ATT_TILE + loff) = vr0; *(LAS bf16x8*)(L + ATT_BUF + loff) = kr1; *(LAS bf16x8*)(L + ATT_BUF + ATT_TILE + loff) = vr1;
    __syncthreads();
    for (int p = 0; p < np; ++p) {
        int ktn = kt;
        if (p + 1 < np) { ktn = pair_tile(p + 1);
            kr0 = *(const bf16x8*)(kg + (size_t)ktn * 64 * NQKV); vr0 = *(const bf16x8*)(vg + ktn * 64);
            kr1 = *(const bf16x8*)(kg + (size_t)(ktn + 1) * 64 * NQKV); vr1 = *(const bf16x8*)(vg + (ktn + 1) * 64); }
        const LAS bf16_t* G = L + (p & 1) * 2 * ATT_BUF;
        const bool own = p < 2;
        const int nblk = kt >> 2;
        const int mysel = (selmask >> nblk) & 1;
        const bool wave_need = own || (((wavemask >> nblk) & 1) != 0);
        if (wave_need) {
            const float bias = (own || mysel) ? 0.f : -1e30f;
#pragma unroll
            for (int i = 0; i < 2; ++i) {
                const LAS bf16_t* Kt = G + i * ATT_BUF; const LAS bf16_t* Vt = Kt + ATT_TILE;
#pragma unroll
                for (int sb = 0; sb < 2; ++sb) {
                    const int kb = 2 * (kt + i) + sb;
                    if (!own || kb <= qt) {
                        bf16x8 kf[4], vf[2][2]; lds_kf(kf, Kt, sb, r, h); lds_vf(vf, Vt, sb, r, h);
                        f32x16 st = qk4(kf, qf);
                        if (own && kb == qt) apply_mask(st, kb * 32, -BIGI, qidx, h);
                        softmax_pv(st, m, l, oa, ob, sc, vf, bias);
                    }
                }
            }
        }
        if (p + 1 < np) { LAS bf16_t* Gn = L + ((p + 1) & 1) * 2 * ATT_BUF;
            *(LAS bf16x8*)(Gn + loff) = kr0; *(LAS bf16x8*)(Gn + ATT_TILE + loff) = vr0; *(LAS bf16x8*)(Gn + ATT_BUF + loff) = kr1; *(LAS bf16x8*)(Gn + ATT_BUF + ATT_TILE + loff) = vr1; }
        __syncthreads();
        kt = ktn;
    }
    bf16_t* orow = (bf16_t*)(c.p->ws + WS_MIXED) + tok_q * D + 640 + hd * 64;
    store_o_rows(orow, D, oa, ob, 1.0f / l, lane, O_STG(c));
}

DI void attn_M_item(const Ctx& c, int b, int hd, int qt) {
    const int lane = c.lane, r = lane & 31, h = lane >> 5;
    const unsigned char* big = c.p->ws + WS_BIG;
    const size_t tok_q = (size_t)b * SEQ + qt * 32 + r;
    const bf16_t* qrow = (const bf16_t*)(big + BIG_QM) + tok_q * 256 + hd * 64 + 8 * h;
    bf16x8 qf[4];
#pragma unroll
    for (int s = 0; s < 4; ++s) qf[s] = *(const bf16x8*)(qrow + 16 * s);
    const bf16_t* kbase = (const bf16_t*)(c.p->ws + WS_KVM) + ((size_t)b * MEMLEN + r) * 512 + hd * 64 + 8 * h;
    const bf16_t* vt = (const bf16_t*)(c.p->ws + WS_VTM) + ((size_t)(b * 4 + hd) * 64 + r) * MEMLEN + 4 * h;
    float m = -1e30f, l = 0.f; f32x16 oa = zero16(), ob = zero16();
    const float sc = 0.125f * LOG2E;
    bf16x8 kf[4]; load_kf(kf, kbase);
    for (int kb = 0; kb < 8; ++kb) {
        const int kidx0 = kb * 32;
        bf16x8 vf[2][2]; load_vf(vf, vt + kidx0, MEMLEN);
        bf16x8 kn[4]; load_kf(kn, kbase + (size_t)(kb < 7 ? kidx0 + 32 : kidx0) * 512);
        const f32x16 st = qk4(kf, qf);
        softmax_pv(st, m, l, oa, ob, sc, vf);
#pragma unroll
        for (int s = 0; s < 4; ++s) kf[s] = kn[s];
    }
    bf16_t* orow = (bf16_t*)(big + BIG_OM) + tok_q * 256 + hd * 64;
    store_o_rows(orow, 256, oa, ob, 1.0f / l, lane, O_STG(c));
}

constexpr int PH_CONV = 0, PH_GU1 = 1, PH_DN1 = 2, PH_WIN = 3, PH_POST = 4, PH_ATT = 5, PH_MERGE = 6, PH_WOUT = 7, PH_MQ = 8, PH_MATT = 9,
              PH_MO = 10, PH_GU2 = 11, PH_DN2 = 12, PH_PER_LAYER = 13, PH_FINAL = 2 * PH_PER_LAYER, PH_TOTAL = PH_FINAL + 1;

DI float lam_init_of(int l) { return l == 0 ? 0.2f : 0.8f - 0.6f * 0.7408182206817179f; }
DI float* ssq_buf(unsigned char* ws, int l, int k) { return (float*)(ws + WS_SSQ) + (size_t)(l * 4 + k) * MTOK; }

DI void phase_conv(const Ctx& c) {
    CParams& P = *c.p; const int l = c.l;
    bf16_t* Wb = (bf16_t*)(P.ws + WS_W);
    LAS float* scr = (LAS float*)(c.lds + c.wave * 8448);
    constexpr int I_G = (D / 64) * (FF / 32), I_D = (FF / 64) * (D / 32), I_IN = (D / 64) * (NQKV / 32), I_OUT = (D / 64) * (D / 32), I_MQ = (D / 64) * (256 / 32),
                  I_MKV = (D / 64) * (512 / 32), I_MO = (256 / 64) * (D / 32);
    constexpr int NITEMS = 4 * I_G + 2 * I_D + I_IN + I_OUT + I_MQ + I_MKV + I_MO;
    const float* g1 = P.in[3] + (size_t)l * D; const float* g2 = P.in[20] + (size_t)l * D; const float* gm = P.in[7] + (size_t)l * D; const float* gq = P.in[15] + (size_t)l * D;
    for (int it = c.gw; it < NITEMS; it += c.ngw) {
        int r = it;
        if (r < I_G) { transpose_item(P.in[4] + (size_t)l * D * FF, D, FF, Wb + W_GU1, 3, 0, scr, r, c.lane, g1); continue; } r -= I_G;
        if (r < I_G) { transpose_item(P.in[5] + (size_t)l * D * FF, D, FF, Wb + W_GU1, 3, 4, scr, r, c.lane, g1); continue; } r -= I_G;
        if (r < I_D) { transpose_item(P.in[6] + (size_t)l * D * FF, FF, D, Wb + W_DN1, 2, 0, scr, r, c.lane); continue; } r -= I_D;
        if (r < I_G) { transpose_item(P.in[21] + (size_t)l * D * FF, D, FF, Wb + W_GU2, 3, 0, scr, r, c.lane, g2); continue; } r -= I_G;
        if (r < I_G) { transpose_item(P.in[22] + (size_t)l * D * FF, D, FF, Wb + W_GU2, 3, 4, scr, r, c.lane, g2); continue; } r -= I_G;
        if (r < I_D) { transpose_item(P.in[23] + (size_t)l * D * FF, FF, D, Wb + W_DN2, 2, 0, scr, r, c.lane); continue; } r -= I_D;
        if (r < I_IN) { transpose_item(P.in[8] + (size_t)l * D * NQKV, D, NQKV, Wb + W_IN, 2, 0, scr, r, c.lane, gm); continue; } r -= I_IN;
        if (r < I_OUT) { transpose_item(P.in[9] + (size_t)l * D * D, D, D, Wb + W_OUT, 2, 0, scr, r, c.lane); continue; } r -= I_OUT;
        if (r < I_MQ) { transpose_item(P.in[17] + (size_t)l * D * 256, D, 256, Wb + W_MQ, 2, 0, scr, r, c.lane, gq); continue; } r -= I_MQ;
        if (r < I_MKV) { transpose_item(P.in[18] + (size_t)l * D * 512, D, 512, Wb + W_MKV, 2, 0, scr, r, c.lane); continue; } r -= I_MKV;
        transpose_item(P.in[19] + (size_t)l * 256 * D, 256, D, Wb + W_MO, 2, 0, scr, r, c.lane);
    }
    norm_phase(c, P.in[1], P.in[16] + (size_t)l * D, (bf16_t*)(P.ws + WS_MEMN), MROWS);
    if (l == 0) {
        bf16_t* XB = (bf16_t*)(P.ws + WS_H); float* ssq0 = ssq_buf(P.ws, 0, 0);
        for (int m = c.gw; m < MTOK; m += c.ngw) {
            const f32x4* xr = (const f32x4*)(P.in[0] + (size_t)m * D) + c.lane; u32x2* o8 = (u32x2*)(XB + (size_t)m * D) + c.lane; float sq = 0.f;
#pragma unroll
            for (int j = 0; j < 4; ++j) { const f32x4 v = xr[64 * j]; sq += (v.x * v.x + v.y * v.y) + (v.z * v.z + v.w * v.w); u32x2 w; w.x = pk2(v.x, v.y); w.y = pk2(v.z, v.w); o8[64 * j] = w; }
            sq = wave_sum(sq); if (c.lane == 0) ssq0[m] = sq;
        }
        const int gt = c.bid * 512 + c.tid, ngt = c.G * 512;
        for (int i = gt; i < 7 * MTOK; i += ngt) ssq0[MTOK + i] = 0.f;
        const int* pos = (const int*)P.in[2];
        float* cosH = (float*)(P.ws + WS_COSH); float* sinH = (float*)(P.ws + WS_SINH); float* cosA = (float*)(P.ws + WS_COSA); float* sinA = (float*)(P.ws + WS_SINA);
        for (int i = gt; i < MTOK * 8; i += ngt) { const int t = i >> 3, f = i & 7; const float invf = powf(500000.0f, -(float)(2 * f) / 16.0f); const float ang = (float)pos[t] * invf;
            float sn, cs; sincosf(ang, &sn, &cs); cosH[i] = cs; sinH[i] = sn; }
        for (int i = gt; i < MTOK * 4; i += ngt) { const int t = i >> 2, f = i & 3; const float invf = powf(500000.0f, -(float)(2 * f) / 8.0f); const float ang = (float)pos[t] * invf;
            float sn, cs; sincosf(ang, &sn, &cs); cosA[i] = cs; sinA[i] = sn; }
        if (c.bid == 0 && c.wave == 0) {
            unsigned* cnt = (unsigned*)(P.ws + WS_MISC);
            cnt[c.lane] = 0u;
            float* lamp = (float*)(P.ws + WS_MISC + 256);
            for (int ll = 0; ll < 2; ++ll) {
                float a = 0.f, bsum = 0.f;
                if (c.lane < 32) { a = P.in[10][ll * 32 + c.lane] * P.in[11][ll * 32 + c.lane]; bsum = P.in[12][ll * 32 + c.lane] * P.in[13][ll * 32 + c.lane]; }
                a = wave_sum(a); bsum = wave_sum(bsum);
                if (c.lane == 0) lamp[ll] = expf(a) - expf(bsum) + lam_init_of(ll);
            }
        }
    }
}

DI void kmean_item(const Ctx& c, int item) {
    CParams& P = *c.p; const int lane = c.lane;
    const int qr = item & 3, it4 = item >> 2, hd = it4 >> 7, tb = it4 & 127, tok0 = tb * 256 + qr * 64;
    bf16_t* base = (bf16_t*)(P.ws + WS_BIG) + (size_t)tok0 * NQKV + COL_KC + hd * 64 + lane;
    const float* cosT = (const float*)(P.ws + WS_COSH); const float* sinT = (const float*)(P.ws + WS_SINH);
    const bool rot = lane < 16, first = lane < 8; const int fi = lane & 7;
    float sum = 0.f;
    for (int t0 = 0; t0 < 64; t0 += 16) {
        float own[16], cs[16], sn[16];
#pragma unroll
        for (int j = 0; j < 16; ++j) { own[j] = bfu2f(base[(size_t)(t0 + j) * NQKV]); cs[j] = rot ? cosT[(size_t)(tok0 + t0 + j) * 8 + fi] : 1.f; sn[j] = rot ? sinT[(size_t)(tok0 + t0 + j) * 8 + fi] : 0.f; }
#pragma unroll
        for (int j = 0; j < 16; ++j) {
            const float par = __shfl_xor(own[j], 8);
            float v = own[j];
            if (rot) { v = first ? (own[j] * cs[j] - par * sn[j]) : (own[j] * cs[j] + par * sn[j]); base[(size_t)(t0 + j) * NQKV] = f2bf(v); }
            sum += v;
        }
    }
    const int b = tb >> 3, n = tb & 7; atomicAdd((float*)(P.ws + WS_MISC + 4096) + ((size_t)(b * 6 + hd) * 8 + n) * 64 + lane, sum * (1.0f / 256.0f));
}

DI void rot_fast(const Ctx& c) {
    CParams& P = *c.p;
    bf16_t* QKV = (bf16_t*)(P.ws + WS_BIG);
    const float* cosH = (const float*)(P.ws + WS_COSH); const float* sinH = (const float*)(P.ws + WS_SINH); const float* cosA = (const float*)(P.ws + WS_COSA); const float* sinA = (const float*)(P.ws + WS_SINA);
    const int gt = c.bid * 512 + c.tid, ngt = c.G * 512;
    for (int i0 = gt; i0 < MTOK * 18; i0 += 4 * ngt) {
        bf16x8 a[4], b[4]; f32x4 c0[4], c1[4], s0[4], s1[4]; bf16_t* pp[4];
#pragma unroll
        for (int u = 0; u < 4; ++u) { const int i = i0 + u * ngt; const bool ok = i < MTOK * 18; const int ii = ok ? i : 0; const int tok = ii / 18, sl = ii % 18;
            const int col = sl < 6 ? COL_QB + sl * 64 : (sl < 12 ? COL_KB + (sl - 6) * 64 : COL_QC + (sl - 12) * 64);
            pp[u] = ok ? QKV + (size_t)tok * NQKV + col : nullptr;
            a[u] = *(const bf16x8*)(QKV + (size_t)tok * NQKV + col); b[u] = *(const bf16x8*)(QKV + (size_t)tok * NQKV + col + 8);
            const f32x4* cp = (const f32x4*)(cosH + (size_t)tok * 8); const f32x4* sp = (const f32x4*)(sinH + (size_t)tok * 8);
            c0[u] = cp[0]; c1[u] = cp[1]; s0[u] = sp[0]; s1[u] = sp[1]; }
#pragma unroll
        for (int u = 0; u < 4; ++u) {
            float o1[8], o2[8];
#pragma unroll
            for (int j = 0; j < 8; ++j) { const float x1 = bf2f(a[u][j]), x2 = bf2f(b[u][j]); const float cs = j < 4 ? c0[u][j & 3] : c1[u][j & 3], sn = j < 4 ? s0[u][j & 3] : s1[u][j & 3];
                o1[j] = x1 * cs - x2 * sn; o2[j] = x2 * cs + x1 * sn; }
            u32x4 w1, w2; w1.x = pk2(o1[0], o1[1]); w1.y = pk2(o1[2], o1[3]); w1.z = pk2(o1[4], o1[5]); w1.w = pk2(o1[6], o1[7]);
            w2.x = pk2(o2[0], o2[1]); w2.y = pk2(o2[2], o2[3]); w2.z = pk2(o2[4], o2[5]); w2.w = pk2(o2[6], o2[7]);
            if (pp[u]) { *(u32x4*)pp[u] = w1; *(u32x4*)(pp[u] + 8) = w2; }
        }
    }
    for (int i0 = gt; i0 < MTOK * 16; i0 += 4 * ngt) {
        bf16x8 a[4]; f32x4 c0[4], s0[4]; bf16_t* pp[4];
#pragma unroll
        for (int u = 0; u < 4; ++u) { const int i = i0 + u * ngt; const bool ok = i < MTOK * 16; const int ii = ok ? i : 0; const int tok = ii >> 4, sl = ii & 15;
            pp[u] = ok ? QKV + (size_t)tok * NQKV + sl * 32 : nullptr;
            a[u] = *(const bf16x8*)(QKV + (size_t)tok * NQKV + sl * 32);
            c0[u] = *(const f32x4*)(cosA + (size_t)tok * 4); s0[u] = *(const f32x4*)(sinA + (size_t)tok * 4); }
#pragma unroll
        for (int u = 0; u < 4; ++u) {
            float o[8];
#pragma unroll
            for (int j = 0; j < 4; ++j) { const float x1 = bf2f(a[u][j]), x2 = bf2f(a[u][4 + j]); o[j] = x1 * c0[u][j] - x2 * s0[u][j]; o[4 + j] = x2 * c0[u][j] + x1 * s0[u][j]; }
            u32x4 w; w.x = pk2(o[0], o[1]); w.y = pk2(o[2], o[3]); w.z = pk2(o[4], o[5]); w.w = pk2(o[6], o[7]);
            if (pp[u]) *(u32x4*)pp[u] = w;
        }
    }
}

DI void phase_post(const Ctx& c) {
    CParams& P = *c.p;
    constexpr int N_KM = 4 * 6 * 128, N_VT = 16 * 16 * 32;
    LAS bf16_t* tile = (LAS bf16_t*)(c.lds + c.wave * 9216);
    const bf16_t* QKV = (const bf16_t*)(P.ws + WS_BIG);
    for (int it = c.gw; it < N_KM + N_VT; it += c.ngw) {
        if (it < N_KM) { kmean_item(c, it); continue; }
        const int v = it - N_KM; const int sl = v / 512, rem = v % 512, b = rem >> 5, t0 = (rem & 31) * 64;
        bf16x8 vv[8];
        if (sl < 6) {
            vt_load(vv, QKV + ((size_t)b * SEQ + t0) * NQKV + COL_VB + sl * 64, NQKV, c.lane);
#pragma unroll
            for (int br = 0; br < 3; ++br) vt_item(vv, (bf16_t*)(P.ws + WS_VT) + (size_t)((10 + sl * 3 + br) * 16 + b) * 64 * SEQ, SEQ, t0, 2 * br, SEQ >> (2 * br), tile, c.lane);
        } else {
            const int slot = sl - 6; const int col = slot < 4 ? COL_VA + slot * 64 : COL_VC + (slot - 4) * 64;
            vt_load(vv, QKV + ((size_t)b * SEQ + t0) * NQKV + col, NQKV, c.lane);
            vt_item(vv, (bf16_t*)(P.ws + WS_VT) + (size_t)(slot * 16 + b) * 64 * SEQ, SEQ, t0, 0, SEQ, tile, c.lane);
        }
    }
    rot_fast(c);
}

DI void phase_att(const Ctx& c) {
    CParams& P = *c.p; const int l = c.l;
    unsigned* cnt = (unsigned*)(P.ws + WS_MISC) + 2 * l;
    const float lam = ((const float*)(P.ws + WS_MISC + 256))[l];
    const float lam_init = lam_init_of(l);
    const float* subln = P.in[14] + l * 64;
    LAS int* slot = (LAS int*)(c.lds + ATT_FLAGS + 64);
    for (;;) {
        if (c.tid == 0) slot[0] = (int)atomicAdd(cnt, 1u);
        __syncthreads();
        const int it = __builtin_amdgcn_readfirstlane(slot[0]);
        __syncthreads();
        if (it >= 8 * 160 + 3 * 768) break;
        if (it < 8 * 160) {
            const int lev = 7 - it / 160, sub = it % 160;
            if (sub < 64) attn_A_unit(c, sub >> 2, sub & 3, lev, lam, lam_init, subln);
            else { const int s2 = sub - 64; attn_C_unit(c, s2 / 6, s2 % 6, lev); }
        } else {
            const int v0 = it - 8 * 160; const int br = v0 / 768, v = v0 % 768; const int b = v / 48, rem = v % 48, hd = rem >> 3, x = rem & 7;
            if (br < 2) attn_B_unit(c, br, b, hd, br == 0 ? 0 : (x >> 1), br == 0 ? x : (x & 1));
            else attn_B2_unit(c, b, hd, x);
        }
    }
#if 0
    constexpr int N2 = 16 * 6 * 64;
    for (;;) {
        int it = 0;
        if (c.lane == 0) it = (int)atomicAdd(cnt + 1, 1u);
        it = __builtin_amdgcn_readfirstlane(it);
        if (it >= N2) break;
        const int tile = it & 63, rest = it >> 6; const int hd = rest % 6, b = rest / 6;
        attn_B_item(c, 2, b, hd, tile);
    }
#endif
}

DI void phase_merge(const Ctx& c) {
    CParams& P = *c.p;
    const bf16_t* part = (const bf16_t*)(P.ws + WS_H); const float* lse = (const float*)(P.ws + WS_LSE); bf16_t* mixed = (bf16_t*)(P.ws + WS_MIXED);
    const int gt = c.bid * 512 + c.tid, ngt = c.G * 512;
    constexpr int NI = MTOK * 48;
    for (int i0 = gt; i0 < NI; i0 += 4 * ngt) {
        float lv[4][3]; bf16x8 pv[4][3]; bf16_t* dst[4];
#pragma unroll
        for (int u = 0; u < 4; ++u) { const int i = i0 + u * ngt; const bool ok = i < NI; const int ii = ok ? i : 0; const int tok = ii / 48, rem = ii % 48, hd = rem >> 3, g8 = rem & 7;
            dst[u] = ok ? mixed + (size_t)tok * D + 256 + hd * 64 + g8 * 8 : nullptr;
#pragma unroll
            for (int k = 0; k < 3; ++k) { lv[u][k] = lse[((size_t)k * MTOK + tok) * 6 + hd]; pv[u][k] = *(const bf16x8*)(part + ((size_t)k * MTOK + tok) * 384 + hd * 64 + g8 * 8); } }
#pragma unroll
        for (int u = 0; u < 4; ++u) {
            const float mx = fmaxf(lv[u][0], fmaxf(lv[u][1], lv[u][2]));
            float w0 = __builtin_amdgcn_exp2f(lv[u][0] - mx), w1 = __builtin_amdgcn_exp2f(lv[u][1] - mx), w2 = __builtin_amdgcn_exp2f(lv[u][2] - mx);
            const float inv = 1.0f / (w0 + w1 + w2); w0 *= inv; w1 *= inv; w2 *= inv;
            float o[8];
#pragma unroll
            for (int j = 0; j < 8; ++j) o[j] = w0 * bf2f(pv[u][0][j]) + w1 * bf2f(pv[u][1][j]) + w2 * bf2f(pv[u][2][j]);
            u32x4 w; w.x = pk2(o[0], o[1]); w.y = pk2(o[2], o[3]); w.z = pk2(o[4], o[5]); w.w = pk2(o[6], o[7]);
            if (dst[u]) *(u32x4*)dst[u] = w;
        }
    }
}

template <class Epi> DI void run_gemm(const Ctx& c, const bf16_t* A, const bf16_t* Bt, int M, int N, int K, const Epi& E, int off = 0) {
    pg8::Gemm g{A, Bt, M, N, K}; pg8::StaticOrder S; S.init(M, N, c.G, (c.bid + c.G - off) % c.G);
    pg8::gemm_phase<Epi, pg8::StaticOrder>(c.lds, g, S, E, c.tid);
}

__global__ void __launch_bounds__(512, 2) mega(Params Parg) {
    extern __shared__ __attribute__((aligned(16))) unsigned char lds_raw[];
    cg::grid_group grid = cg::this_grid();
    const int ph_lo = Parg.lo, ph_hi = Parg.hi;
#ifdef PROBE_MASK
    unsigned long long tacc = 0, tstart = 0; int qprev = -1;
#endif
    unsigned bar_gen = 0;
    for (int ph = ph_lo; ph < ph_hi; ++ph) {
        if (ph == ph_lo + 1) grid.sync();
        else if (ph != ph_lo) grid_barrier((unsigned*)(Parg.ws + WS_BAR), gridDim.x, bar_gen);
#ifdef PROBE_MASK
        { const unsigned long long tn = __builtin_amdgcn_s_memrealtime(); if (qprev >= 0 && ((PROBE_MASK >> qprev) & 1)) tacc += tn - tstart; tstart = tn; qprev = (ph == PH_FINAL) ? -1 : ph % PH_PER_LAYER; }
#endif
        int tid_l = threadIdx.x; asm volatile("" : "+v"(tid_l));
        unsigned long long kpu = (unsigned long long)__builtin_amdgcn_kernarg_segment_ptr(); asm volatile("" : "+s"(kpu));
        Ctx c; c.p = (CParams*)kpu; c.tid = tid_l; c.lane = c.tid & 63; c.wave = __builtin_amdgcn_readfirstlane(c.tid >> 6);
        int G_l = gridDim.x, bid_l = blockIdx.x; asm volatile("" : "+s"(G_l), "+s"(bid_l));
        c.G = G_l; c.bid = bid_l; c.gw = c.bid * 8 + c.wave; c.ngw = c.G * 8; c.lds = (LAS unsigned char*)lds_raw;
#define PHASE_BEGIN unsigned long long kpl_ = kpu; asm volatile("" : "+s"(kpl_)); c.p = (CParams*)kpl_; CParams& P = *c.p; unsigned char* ws = P.ws; \
        bf16_t* Wb = (bf16_t*)(ws + WS_W); bf16_t* XB = (bf16_t*)(ws + WS_H); bf16_t* ACT = (bf16_t*)(ws + WS_BIG); bf16_t* MIXED = (bf16_t*)(ws + WS_MIXED); (void)Wb; (void)XB; (void)ACT; (void)MIXED;
        if (ph == PH_FINAL) {
            PHASE_BEGIN
            for (int m = c.gw; m < MTOK; m += c.ngw) norm_row_f32(P.out + (size_t)m * D, P.in[24], P.out + (size_t)m * D, c.lane);
            continue;
        }
        const int l = ph / PH_PER_LAYER, q = ph % PH_PER_LAYER; c.l = l;
        switch (q) {
        case PH_CONV: { PHASE_BEGIN phase_conv(c); } break;
        case PH_GU1: { PHASE_BEGIN pg8::EpiSwiglu E{ACT, ssq_buf(ws, l, 0)}; run_gemm(c, XB, Wb + W_GU1, MTOK, 2 * FF, D, E); } break;
        case PH_DN1: { PHASE_BEGIN pg8::EpiResid E{(l == 0) ? P.in[0] : P.out, P.out, 0.5f, XB, ssq_buf(ws, l, 1)}; run_gemm(c, ACT, Wb + W_DN1, MTOK, D, FF, E); } break;
        case PH_WIN: { PHASE_BEGIN
            { float* kmz = (float*)(ws + WS_MISC + 4096); for (int i = c.bid * 512 + c.tid; i < 16 * 6 * 8 * 64; i += c.G * 512) kmz[i] = 0.f; }
            pg8::EpiStore E{ACT, NQKV, ssq_buf(ws, l, 1)}; run_gemm(c, XB, Wb + W_IN, MTOK, NQKV, D, E); } break;
        case PH_POST: { PHASE_BEGIN phase_post(c); } break;
        case PH_ATT: { PHASE_BEGIN phase_att(c); } break;
        case PH_MERGE: { PHASE_BEGIN phase_merge(c); } break;
        case PH_WOUT: { PHASE_BEGIN pg8::EpiResid E{P.out, P.out, 1.0f, XB, ssq_buf(ws, l, 2)}; run_gemm(c, MIXED, Wb + W_OUT, MTOK, D, D, E); } break;
        case PH_MQ: { PHASE_BEGIN
            pg8::EpiStore E{(bf16_t*)(ws + WS_BIG + BIG_QM), 256, ssq_buf(ws, l, 2)}; run_gemm(c, XB, Wb + W_MQ, MTOK, 256, D, E);
            pg8::EpiStoreKV E2{(bf16_t*)(ws + WS_KVM), (bf16_t*)(ws + WS_VTM)}; run_gemm(c, (const bf16_t*)(ws + WS_MEMN), Wb + W_MKV, MROWS, 512, D, E2, 128);
        } break;
        case PH_MATT: { PHASE_BEGIN } for (int it = c.gw; it < 16 * 4 * 64; it += c.ngw) attn_M_item(c, it >> 8, (it >> 6) & 3, it & 63); break;
        case PH_MO: { PHASE_BEGIN pg8::EpiResid E{P.out, P.out, 1.0f, XB, ssq_buf(ws, l, 3)}; run_gemm(c, (const bf16_t*)(ws + WS_BIG + BIG_OM), Wb + W_MO, MTOK, D, 256, E); } break;
        case PH_GU2: { PHASE_BEGIN pg8::EpiSwiglu E{ACT, ssq_buf(ws, l, 3)}; run_gemm(c, XB, Wb + W_GU2, MTOK, 2 * FF, D, E); } break;
        case PH_DN2: { PHASE_BEGIN pg8::EpiResid E{P.out, P.out, 0.5f, (l == 0) ? XB : nullptr, (l == 0) ? ssq_buf(ws, 1, 0) : nullptr}; run_gemm(c, ACT, Wb + W_DN2, MTOK, D, FF, E); } break;
        default: break;
        }
    }
#ifdef PROBE_MASK
    if (blockIdx.x == 0) { const unsigned long long tend = __builtin_amdgcn_s_memrealtime() + tacc * PROBE_MULT; while (__builtin_amdgcn_s_memrealtime() < tend) __builtin_amdgcn_s_sleep(32); }
#endif
}

constexpr int LDS_BYTES = 135168;

extern "C" void kernel_launch(void* const* d_in, const int* in_sizes, int n_in, void* d_out, int out_size, void* d_ws, size_t ws_size, hipStream_t stream) {
    static int grid = 0;
    if (grid == 0) {
        if (n_in != 25 || out_size != MTOK * D || ws_size < WS_END) { fprintf(stderr, "kernel_launch: unexpected shapes (n_in %d out %d ws %zu)\n", n_in, out_size, ws_size); grid = -1; return; }
        int dev = 0, cus = 0, per_cu = 0;
        hipGetDevice(&dev);
        hipDeviceGetAttribute(&cus, hipDeviceAttributeMultiprocessorCount, dev);
        if (hipFuncSetAttribute((const void*)mega, hipFuncAttributeMaxDynamicSharedMemorySize, LDS_BYTES) != hipSuccess) { fprintf(stderr, "kernel_launch: hipFuncSetAttribute failed\n"); grid = -1; return; }
        if (hipOccupancyMaxActiveBlocksPerMultiprocessor(&per_cu, (const void*)mega, 512, LDS_BYTES) != hipSuccess || per_cu < 1) { fprintf(stderr, "kernel_launch: occupancy query gave %d\n", per_cu); per_cu = 1; }
        (void)hipGetLastError();
        grid = cus * per_cu;
    }
    if (grid < 0) return;
    if (hipMemsetAsync((char*)d_ws + WS_BAR, 0, 1024, stream) != hipSuccess) { fprintf(stderr, "kernel_launch: memset failed\n"); return; }
    Params p{};
    for (int i = 0; i < 25; ++i) p.in[i] = (const float*)d_in[i];
    p.out = (float*)d_out; p.ws = (unsigned char*)d_ws;
#ifdef MK_PER_PHASE
    for (int ph = 0; ph < PH_TOTAL; ++ph) { p.lo = ph; p.hi = ph + 1; hipLaunchKernelGGL(mega, dim3(grid), dim3(512), LDS_BYTES, stream, p); }
#else
    p.lo = 0; p.hi = PH_TOTAL;
    void* args[] = {&p};
    hipError_t e = hipLaunchCooperativeKernel((const void*)mega, dim3(grid), dim3(512), args, LDS_BYTES, stream);
    if (e != hipSuccess) fprintf(stderr, "cooperative launch failed: %s (grid %d)\n", hipGetErrorString(e), grid);
#endif
}
```

```cpp
#include <hip/hip_runtime.h>
#include <hip/hip_cooperative_groups.h>
#include <cstdio>
#include <cstdint>
namespace cg = cooperative_groups;

#define DI __device__ __forceinline__
#define LAS __attribute__((address_space(3)))
typedef unsigned short bf16_t;
typedef short bf16x8 __attribute__((ext_vector_type(8)));
typedef short s16x4 __attribute__((ext_vector_type(4)));
typedef float f32x4 __attribute__((ext_vector_type(4)));
typedef float f32x2 __attribute__((ext_vector_type(2)));
typedef float f32x16 __attribute__((ext_vector_type(16)));
typedef unsigned u32x4 __attribute__((ext_vector_type(4)));
typedef unsigned u32x2 __attribute__((ext_vector_type(2)));
typedef __bf16 bf2_t __attribute__((ext_vector_type(2)));

constexpr int BATCH = 16, SEQ = 2048, D = 1024, MTOK = BATCH * SEQ, FF = 2816, MEMLEN = 256, MROWS = BATCH * MEMLEN, NQKV = 3072;
constexpr int COL_QA = 0, COL_KA = 256, COL_VA = 512, COL_QB = 768, COL_KB = 1152, COL_VB = 1536, COL_QC = 1920, COL_KC = 2304, COL_VC = 2688;
constexpr float EPS = 1e-6f;
constexpr float LOG2E = 1.4426950408889634f;

constexpr size_t MiB = 1u << 20;
constexpr size_t WS_MISC = 0;
constexpr size_t WS_BAR = 512 * 1024;
constexpr size_t WS_SSQ = 47 * MiB;
constexpr size_t WS_COSH = 1 * MiB, WS_SINH = 2 * MiB, WS_COSA = 3 * MiB, WS_SINA = 3 * MiB + 512 * 1024;
constexpr size_t WS_W = 4 * MiB;
constexpr size_t WS_H = 48 * MiB;
constexpr size_t WS_LSE = 120 * MiB;
constexpr size_t WS_BIG = 123 * MiB;
constexpr size_t WS_MIXED = 315 * MiB;
constexpr size_t WS_VT = 379 * MiB;
constexpr size_t WS_MEMN = 491 * MiB, WS_KVM = 499 * MiB, WS_VTM = 503 * MiB;
constexpr size_t WS_END = 505 * MiB;
constexpr size_t W_GU1 = 0, W_DN1 = W_GU1 + (size_t)2 * FF * D, W_GU2 = W_DN1 + (size_t)D * FF, W_DN2 = W_GU2 + (size_t)2 * FF * D,
                 W_IN = W_DN2 + (size_t)D * FF, W_OUT = W_IN + (size_t)NQKV * D, W_MQ = W_OUT + (size_t)D * D, W_MKV = W_MQ + (size_t)256 * D,
                 W_MO = W_MKV + (size_t)512 * D, W_ENDE = W_MO + (size_t)D * 256;
static_assert(W_ENDE * 2 <= 43 * MiB, "weights fit");
constexpr size_t BIG_QM = 16 * MiB, BIG_OM = 32 * MiB;

DI unsigned pk2(float a, float b) { f32x2 v = {a, b}; bf2_t r = __builtin_convertvector(v, bf2_t); return __builtin_bit_cast(unsigned, r); }
DI float bf2f(short s) { return __uint_as_float(((unsigned)(unsigned short)s) << 16); }
DI float bfu2f(bf16_t s) { return __uint_as_float(((unsigned)s) << 16); }
DI bf16_t f2bf(float f) { return (bf16_t)(pk2(f, 0.f) & 0xffffu); }
DI float wave_sum(float v) {
#pragma unroll
    for (int o = 1; o < 64; o <<= 1) v += __shfl_xor(v, o);
    return v;
}

namespace pg8 {
constexpr int BM = 256, BK = 64, HALF = 128, HTB = HALF * BK * 2, STAGE_BYTES = 8 * HTB, NXCD = 8, WGM = 8;
DI int lds_byte(int r, int c) { const int st = (r >> 4) * 2 + (c >> 5), rr = r & 15, cc = c & 31, ob = rr * 64 + cc * 2; return st * 1024 + (ob ^ (((ob >> 9) & 1) << 5)); }
DI void stage_rc(int b, int& R, int& C) { const int st = b / 1024, sb = b % 1024, swz = sb ^ (((sb >> 9) & 1) << 5); R = (st >> 1) * 16 + swz / 64; C = (st & 1) * 32 + (swz % 64) / 2; }
DI int perm32(int rho) { const int n = rho >> 4, i = rho & 15; return 8 * (i >> 2) + 4 * n + (i & 3); }
struct Unit { int pm, pn; };
struct Gemm { const bf16_t* A; const bf16_t* Bt; int M, N, K; };
struct StaticOrder {
    int nM, nN, nwg, G, c;
    DI void init(int M, int N, int G_, int c_) { nM = M / BM; nN = N / BM; nwg = nM * nN; G = G_; c = c_; }
    DI bool next(int i, Unit& u) const {
        const long L = (long)i * G + c; if (L >= nwg) return false;
        int wgid = (int)L; { const int q = nwg / NXCD, r = nwg % NXCD, xcd = wgid % NXCD, off = wgid / NXCD; wgid = (xcd < r ? xcd * (q + 1) : r * (q + 1) + (xcd - r) * q) + off; }
        const int nig = WGM * nN, gid = wgid / nig, fm = gid * WGM, gsz = (nM - fm) < WGM ? (nM - fm) : WGM;
        u.pm = fm + ((wgid % nig) % gsz); u.pn = (wgid % nig) / gsz; return true;
    }
};
DI unsigned cvt_pk_bf16(float lo, float hi) { unsigned r; asm volatile("v_cvt_pk_bf16_f32 %0, %1, %2" : "=v"(r) : "v"(lo), "v"(hi)); return r; }

DI float rstd_of(const float* ssq, int row) { return ssq ? 1.0f / sqrtf(ssq[row] * (1.f / D) + EPS) : 1.0f; }
struct EpiStore {
    static constexpr bool PERM = true;
    bf16_t* O; int ldc; const float* ssq;
    DI void operator()(const f32x4 (&acc)[2][2][4][2], const Unit& u, int wr, int wc, int fr, int fq) const {
        const int row0 = u.pm * BM + wr * 64 + fr, col0 = u.pn * BM + wc * 32 + 8 * fq;
        float rsv[2][4];
#pragma unroll
        for (int ai = 0; ai < 2; ++ai)
#pragma unroll
            for (int m = 0; m < 4; ++m) rsv[ai][m] = ssq ? ssq[row0 + ai * HALF + m * 16] : 0.f;
#pragma unroll
        for (int ai = 0; ai < 2; ++ai)
#pragma unroll
            for (int m = 0; m < 4; ++m) { bf16_t* rowp = O + (size_t)(row0 + ai * HALF + m * 16) * ldc + col0; const float rs = ssq ? 1.0f / sqrtf(rsv[ai][m] * (1.f / D) + EPS) : 1.0f;
#pragma unroll
                for (int bj = 0; bj < 2; ++bj) { const f32x4 v0 = acc[ai][bj][m][0] * rs, v1 = acc[ai][bj][m][1] * rs;
                    u32x4 w; w.x = cvt_pk_bf16(v0[0], v0[1]); w.y = cvt_pk_bf16(v0[2], v0[3]); w.z = cvt_pk_bf16(v1[0], v1[1]); w.w = cvt_pk_bf16(v1[2], v1[3]);
                    *(u32x4*)(rowp + bj * HALF) = w; } }
    }
};
struct EpiStoreKV {
    static constexpr bool PERM = true;
    bf16_t* O; bf16_t* VT_;
    DI void operator()(const f32x4 (&acc)[2][2][4][2], const Unit& u, int wr, int wc, int fr, int fq) const {
        const int row0 = u.pm * BM + wr * 64 + fr, col0 = u.pn * BM + wc * 32 + 8 * fq;
#pragma unroll
        for (int ai = 0; ai < 2; ++ai)
#pragma unroll
            for (int m = 0; m < 4; ++m) { const int row = row0 + ai * HALF + m * 16;
#pragma unroll
                for (int bj = 0; bj < 2; ++bj) { const f32x4 v0 = acc[ai][bj][m][0], v1 = acc[ai][bj][m][1]; const int col = col0 + bj * HALF;
                    if (u.pn == 0) { u32x4 w; w.x = cvt_pk_bf16(v0[0], v0[1]); w.y = cvt_pk_bf16(v0[2], v0[3]); w.z = cvt_pk_bf16(v1[0], v1[1]); w.w = cvt_pk_bf16(v1[2], v1[3]);
                        *(u32x4*)(O + (size_t)row * 512 + col) = w; }
                    else { bf16_t* vp = VT_ + ((size_t)(row >> 8) * 256 + (col - 256)) * 256 + (row & 255);
#pragma unroll
                        for (int j = 0; j < 4; ++j) { vp[(size_t)j * 256] = f2bf(v0[j]); vp[(size_t)(4 + j) * 256] = f2bf(v1[j]); } } } }
    }
};
DI float silu_mul(float g, float u) { const float e = __builtin_amdgcn_exp2f(-g * LOG2E); return g * __builtin_amdgcn_rcpf(1.0f + e) * u; }
struct EpiSwiglu {
    static constexpr bool PERM = true;
    bf16_t* O; const float* ssq;
    DI void operator()(const f32x4 (&acc)[2][2][4][2], const Unit& u, int wr, int wc, int fr, int fq) const {
        const int row0 = u.pm * BM + wr * 64 + fr, col0 = u.pn * 128 + wc * 16 + 4 * fq;
        float rsv[2][4];
#pragma unroll
        for (int ai = 0; ai < 2; ++ai)
#pragma unroll
            for (int m = 0; m < 4; ++m) rsv[ai][m] = ssq[row0 + ai * HALF + m * 16];
#pragma unroll
        for (int ai = 0; ai < 2; ++ai)
#pragma unroll
            for (int m = 0; m < 4; ++m) { bf16_t* rowp = O + (size_t)(row0 + ai * HALF + m * 16) * FF + col0; const float rs = 1.0f / sqrtf(rsv[ai][m] * (1.f / D) + EPS);
#pragma unroll
                for (int bj = 0; bj < 2; ++bj) { const f32x4 g = acc[ai][bj][m][0] * rs, up = acc[ai][bj][m][1] * rs;
                    u32x2 w; w.x = cvt_pk_bf16(silu_mul(g[0], up[0]), silu_mul(g[1], up[1])); w.y = cvt_pk_bf16(silu_mul(g[2], up[2]), silu_mul(g[3], up[3]));
                    *(u32x2*)(rowp + bj * 64) = w; } }
    }
};
struct EpiResid {
    static constexpr bool PERM = true;
    const float* xin; float* xout; float scale; bf16_t* xb; float* ssq;
    DI void operator()(const f32x4 (&acc)[2][2][4][2], const Unit& u, int wr, int wc, int fr, int fq) const {
        const int row0 = u.pm * BM + wr * 64 + fr, col0 = u.pn * BM + wc * 32 + 8 * fq;
#pragma unroll
        for (int ai = 0; ai < 2; ++ai) {
            f32x4 xv[4][2][2];
#pragma unroll
            for (int m = 0; m < 4; ++m)
#pragma unroll
                for (int bj = 0; bj < 2; ++bj) { const size_t o = (size_t)(row0 + ai * HALF + m * 16) * D + col0 + bj * HALF; xv[m][bj][0] = *(const f32x4*)(xin + o); xv[m][bj][1] = *(const f32x4*)(xin + o + 4); }
#pragma unroll
            for (int m = 0; m < 4; ++m) { const int row = row0 + ai * HALF + m * 16; const size_t off = (size_t)row * D + col0; float sq = 0.f;
#pragma unroll
                for (int bj = 0; bj < 2; ++bj) { const size_t o = off + bj * HALF;
                    const f32x4 x0 = xv[m][bj][0] + acc[ai][bj][m][0] * scale, x1 = xv[m][bj][1] + acc[ai][bj][m][1] * scale;
                    *(f32x4*)(xout + o) = x0; *(f32x4*)(xout + o + 4) = x1;
                    sq += (x0[0] * x0[0] + x0[1] * x0[1]) + (x0[2] * x0[2] + x0[3] * x0[3]) + (x1[0] * x1[0] + x1[1] * x1[1]) + (x1[2] * x1[2] + x1[3] * x1[3]);
                    if (xb) { u32x4 w; w.x = pk2(x0[0], x0[1]); w.y = pk2(x0[2], x0[3]); w.z = pk2(x1[0], x1[1]); w.w = pk2(x1[2], x1[3]); *(u32x4*)(xb + o) = w; } }
                if (ssq) { sq += __shfl_xor(sq, 16); sq += __shfl_xor(sq, 32); if (fq == 0) atomicAdd(ssq + row, sq); } }
        }
    }
};

template <class Epi, class Sched>
DI void gemm_phase(LAS unsigned char* lds, const Gemm g, const Sched& S, const Epi& E, const int tid) {
    const int wid = __builtin_amdgcn_readfirstlane(tid >> 6), lane = tid & 63, wr = wid >> 2, wc = wid & 3, fr = lane & 15, fq = lane >> 4;
    const int K = g.K, nt = K / BK;
    unsigned voffA[2], voffB[2];
#pragma unroll
    for (int i = 0; i < 2; ++i) { int R, C; stage_rc(tid * 16 + i * 8192, R, C); const int Rb = Epi::PERM ? ((R & ~31) + perm32(R & 31)) : R;
        voffA[i] = (unsigned)(R * K + C) * 2u; voffB[i] = (unsigned)(Rb * K + C) * 2u; }
    const size_t kstep = (size_t)(BK * 2);
    const size_t hstep = (size_t)HALF * K * 2;
    const size_t tstep = 2 * hstep;
    const unsigned ldsw = (unsigned)wid * 1024u;
    const int aoff = lds_byte(wr * 64 + fr, fq * 8), boff = lds_byte(wc * 32 + fr, fq * 8);
#define PG8_SA(b, h) (((b) * 2 + (h)) * HTB)
#define PG8_SB(b, h) ((4 + (b) * 2 + (h)) * HTB)
#define PG8_STAGE(bufoff, gbase, voff) do { _Pragma("unroll") for (int _i = 0; _i < 2; ++_i) \
        __builtin_amdgcn_global_load_lds((const unsigned*)((const char*)(gbase) + (voff)[_i]), (LAS unsigned*)(lds + (bufoff) + ldsw + _i * 8192), 16, 0, 0); } while (0)
#define PG8_LDA(dst, b, h) do { _Pragma("unroll") for (int m = 0; m < 4; ++m) _Pragma("unroll") for (int k = 0; k < 2; ++k) dst[m][k] = *(const LAS bf16x8*)(lds + PG8_SA(b, h) + aoff + m * 2048 + k * 1024); } while (0)
#define PG8_LDB(dst, b, h) do { _Pragma("unroll") for (int n = 0; n < 2; ++n) _Pragma("unroll") for (int k = 0; k < 2; ++k) dst[n][k] = *(const LAS bf16x8*)(lds + PG8_SB(b, h) + boff + n * 2048 + k * 1024); } while (0)
#define PG8_MMA(ai, bj, At, Bt) do { __builtin_amdgcn_s_setprio(1); _Pragma("unroll") for (int m = 0; m < 4; ++m) _Pragma("unroll") for (int n = 0; n < 2; ++n) _Pragma("unroll") for (int k = 0; k < 2; ++k) \
        acc[ai][bj][m][n] = __builtin_amdgcn_mfma_f32_16x16x32_bf16(Bt[n][k], At[m][k], acc[ai][bj][m][n], 0, 0, 0); __builtin_amdgcn_s_setprio(0); } while (0)
#define PG8_WAIT_V(n) asm volatile("s_waitcnt vmcnt(" #n ")" ::: "memory")
#define PG8_WAIT_L(n) asm volatile("s_waitcnt lgkmcnt(" #n ")" ::: "memory")
#define PG8_BAR __builtin_amdgcn_s_barrier()
#define PG8_SCHED __builtin_amdgcn_sched_barrier(0)
    Unit cur, nxt; int ui = 0;
    if (!S.next(0, cur)) return;
    f32x4 acc[2][2][4][2];
#pragma unroll
    for (int a = 0; a < 2; ++a)
#pragma unroll
        for (int b = 0; b < 2; ++b)
#pragma unroll
            for (int m = 0; m < 4; ++m)
#pragma unroll
                for (int n = 0; n < 2; ++n) acc[a][b][m][n] = (f32x4){0.f, 0.f, 0.f, 0.f};
    bf16x8 At[4][2], B0[2][2], B1[2][2];
    const char* cA = (const char*)g.A + (size_t)cur.pm * tstep; const char* cB = (const char*)g.Bt + (size_t)cur.pn * tstep;
    PG8_STAGE(PG8_SB(0, 0), cB, voffB); PG8_STAGE(PG8_SB(0, 1), cB + hstep, voffB); PG8_STAGE(PG8_SA(0, 0), cA, voffA); PG8_STAGE(PG8_SA(0, 1), cA + hstep, voffA);
    if (wr == 1) PG8_BAR;
    PG8_WAIT_V(2); PG8_BAR;
    PG8_STAGE(PG8_SB(1, 0), cB + kstep, voffB); PG8_STAGE(PG8_SA(1, 0), cA + kstep, voffA); PG8_STAGE(PG8_SB(1, 1), cB + hstep + kstep, voffB);
    PG8_WAIT_V(6); PG8_BAR;
    for (;;) {
        const bool has_next = S.next(ui + 1, nxt);
        const char* nA = has_next ? (const char*)g.A + (size_t)nxt.pm * tstep : cA; const char* nB = has_next ? (const char*)g.Bt + (size_t)nxt.pn * tstep : cB;
        for (int t = 0; t < nt; t += 2) {
            const bool last = (t == nt - 2);
            const char* a1 = cA + (size_t)(t + 1) * kstep;
            const char* a2 = last ? nA : cA + (size_t)(t + 2) * kstep; const char* b2 = last ? nB : cB + (size_t)(t + 2) * kstep;
            const char* a3 = a2 + kstep; const char* b3 = b2 + kstep;
            PG8_LDB(B0, 0, 0); PG8_LDB(B1, 0, 1); PG8_SCHED; PG8_LDA(At, 0, 0); PG8_STAGE(PG8_SA(1, 1), a1 + hstep, voffA);
            PG8_WAIT_V(8); PG8_WAIT_L(0); PG8_BAR; PG8_MMA(0, 0, At, B0); PG8_MMA(0, 1, At, B1); PG8_BAR; PG8_SCHED;
            PG8_LDA(At, 0, 1); PG8_STAGE(PG8_SB(0, 0), b2, voffB); PG8_STAGE(PG8_SB(0, 1), b2 + hstep, voffB); PG8_STAGE(PG8_SA(0, 0), a2, voffA);
            PG8_WAIT_V(8); PG8_WAIT_L(0); PG8_BAR; PG8_MMA(1, 0, At, B0); PG8_MMA(1, 1, At, B1); PG8_BAR; PG8_SCHED;
            PG8_LDB(B0, 1, 0); PG8_LDB(B1, 1, 1); PG8_SCHED; PG8_LDA(At, 1, 0); PG8_STAGE(PG8_SA(0, 1), a2 + hstep, voffA);
            PG8_WAIT_V(8); PG8_WAIT_L(0); PG8_BAR; PG8_MMA(0, 0, At, B0); PG8_MMA(0, 1, At, B1); PG8_BAR; PG8_SCHED;
            PG8_LDA(At, 1, 1); PG8_STAGE(PG8_SB(1, 0), b3, voffB); PG8_STAGE(PG8_SB(1, 1), b3 + hstep, voffB); PG8_STAGE(PG8_SA(1, 0), a3, voffA);
            PG8_WAIT_V(8); PG8_WAIT_L(0); PG8_BAR; PG8_MMA(1, 0, At, B0); PG8_MMA(1, 1, At, B1); PG8_BAR; PG8_SCHED;
        }
        if (wr == 0) PG8_BAR;
        E(acc, cur, wr, wc, fr, fq);
        if (!has_next) break;
#pragma unroll
        for (int a = 0; a < 2; ++a)
#pragma unroll
            for (int b = 0; b < 2; ++b)
#pragma unroll
                for (int m = 0; m < 4; ++m)
#pragma unroll
                    for (int n = 0; n < 2; ++n) acc[a][b][m][n] = (f32x4){0.f, 0.f, 0.f, 0.f};
        cur = nxt; cA = nA; cB = nB; ++ui;
        if (wr == 1) PG8_BAR;
    }
    PG8_WAIT_V(0);
    PG8_BAR;
#undef PG8_SA
#undef PG8_SB
#undef PG8_STAGE
#undef PG8_LDA
#undef PG8_LDB
#undef PG8_MMA
#undef PG8_WAIT_V
#undef PG8_WAIT_L
#undef PG8_BAR
#undef PG8_SCHED
}
}

DI void grid_barrier(unsigned* bar, unsigned G, unsigned& gen) {
    __syncthreads();
    if (threadIdx.x == 0) {
        ++gen;
        __builtin_amdgcn_fence(__ATOMIC_RELEASE, "agent");
        const unsigned prev = __hip_atomic_fetch_add(bar, 1u, __ATOMIC_RELAXED, __HIP_MEMORY_SCOPE_AGENT);
        if (prev == G * gen - 1u) __hip_atomic_store(bar + 64, gen, __ATOMIC_RELAXED, __HIP_MEMORY_SCOPE_AGENT);
        else while (__hip_atomic_load(bar + 64, __ATOMIC_RELAXED, __HIP_MEMORY_SCOPE_AGENT) < gen) __builtin_amdgcn_s_sleep(1);
        __builtin_amdgcn_fence(__ATOMIC_ACQUIRE, "agent");
    }
    __syncthreads();
}

struct Params { const float* in[25]; float* out; unsigned char* ws; int lo, hi; };
typedef const __attribute__((address_space(4))) Params CParams;

struct Ctx {
    CParams* p; int l; int tid, lane, wave, gw, ngw, G, bid;
    LAS unsigned char* lds;
};

DI void transpose_item(const float* W, int K, int N, bf16_t* WT, int sh, int add, LAS float* scr, int item, int lane, const float* gain = nullptr) {
    const int nblk = N / 32, kb = item / nblk, nb = item % nblk, k0 = 64 * kb, n0 = 32 * nb;
    f32x4 wv[8];
#pragma unroll
    for (int i = 0; i < 8; ++i) { const int kk = (lane >> 3) + 8 * i; wv[i] = *(const f32x4*)(W + (size_t)(k0 + kk) * N + n0 + 4 * (lane & 7)); }
#pragma unroll
    for (int i = 0; i < 8; ++i) { const int kk = (lane >> 3) + 8 * i; const float gk = gain ? gain[k0 + kk] : 1.0f; LAS float* d = scr + kk * 33 + 4 * (lane & 7);
        d[0] = wv[i].x * gk; d[1] = wv[i].y * gk; d[2] = wv[i].z * gk; d[3] = wv[i].w * gk; }
    asm volatile("s_waitcnt lgkmcnt(0)" ::: "memory");
    const int c = lane & 7;
#pragma unroll
    for (int j = 0; j < 4; ++j) { const int n = (lane >> 3) + 8 * j; const LAS float* s = scr + (8 * c) * 33 + n;
        u32x4 o; o.x = pk2(s[0 * 33], s[1 * 33]); o.y = pk2(s[2 * 33], s[3 * 33]); o.z = pk2(s[4 * 33], s[5 * 33]); o.w = pk2(s[6 * 33], s[7 * 33]);
        const int nn = n0 + n; const int row = ((nn >> 2) << sh) + (nn & 3) + add;
        *(u32x4*)(WT + (size_t)row * K + k0 + 8 * c) = o; }
    asm volatile("s_waitcnt lgkmcnt(0)" ::: "memory");
}

DI void norm_row_bf16(const float* xrow, const float* g, bf16_t* orow, int lane) {
    const f32x4* xr = (const f32x4*)xrow + lane; const f32x4* gr = (const f32x4*)g + lane;
    f32x4 v[4]; float s = 0.f;
#pragma unroll
    for (int j = 0; j < 4; ++j) { v[j] = xr[64 * j]; s += (v[j].x * v[j].x + v[j].y * v[j].y) + (v[j].z * v[j].z + v[j].w * v[j].w); }
    const float rstd = 1.0f / sqrtf(wave_sum(s) * (1.f / D) + EPS);
    u32x2* o8 = (u32x2*)orow + lane;
#pragma unroll
    for (int j = 0; j < 4; ++j) { const f32x4 gv = gr[64 * j]; u32x2 w; w.x = pk2(v[j].x * rstd * gv.x, v[j].y * rstd * gv.y); w.y = pk2(v[j].z * rstd * gv.z, v[j].w * rstd * gv.w); o8[64 * j] = w; }
}
DI void norm_row_f32(const float* xrow, const float* g, float* orow, int lane) {
    const f32x4* xr = (const f32x4*)xrow + lane; const f32x4* gr = (const f32x4*)g + lane;
    f32x4 v[4]; float s = 0.f;
#pragma unroll
    for (int j = 0; j < 4; ++j) { v[j] = xr[64 * j]; s += (v[j].x * v[j].x + v[j].y * v[j].y) + (v[j].z * v[j].z + v[j].w * v[j].w); }
    const float rstd = 1.0f / sqrtf(wave_sum(s) * (1.f / D) + EPS);
    f32x4* o = (f32x4*)orow + lane;
#pragma unroll
    for (int j = 0; j < 4; ++j) { const f32x4 gv = gr[64 * j]; o[64 * j] = v[j] * rstd * gv; }
}
DI void norm_phase(const Ctx& c, const float* x, const float* g, bf16_t* H, int rows) {
    for (int m = c.gw; m < rows; m += c.ngw) norm_row_bf16(x + (size_t)m * D, g, H + (size_t)m * D, c.lane);
}

DI void vt_load(bf16x8 (&v)[8], const bf16_t* src  , int pitch, int lane) {
    const int c8 = (lane & 7) * 8, tr = lane >> 3;
#pragma unroll
    for (int i = 0; i < 8; ++i) v[i] = *(const bf16x8*)(src + (size_t)(tr + 8 * i) * pitch + c8);
}
DI void vt_item(const bf16x8 (&v)[8], bf16_t* dst  , int dst_ld, int t0, int dsh, int L, LAS bf16_t* tile, int lane) {
    const int c8 = (lane & 7) * 8, tr = lane >> 3, d1 = (1 << dsh) - 1;
#pragma unroll
    for (int i = 0; i < 8; ++i) { const int t = tr + 8 * i; const int cp = ((t & d1) << (6 - dsh)) + (t >> dsh);
#pragma unroll
        for (int j = 0; j < 8; ++j) tile[(c8 + j) * 72 + cp] = (bf16_t)v[i][j]; }
    asm volatile("s_waitcnt lgkmcnt(0)" ::: "memory");
    const int seglen = 64 >> dsh;
#pragma unroll
    for (int i = 0; i < 8; ++i) { const int dim = tr + 8 * i; const bf16x8 w = *(const LAS bf16x8*)(tile + dim * 72 + c8);
        bf16_t* drow = dst + (size_t)dim * dst_ld + (t0 >> dsh);
        if (dsh < 4) { const int rr = c8 / seglen, off = c8 % seglen; *(bf16x8*)(drow + (size_t)rr * L + off) = w; }
        else { const int rr = c8 >> 2; *(s16x4*)(drow + (size_t)rr * L) = __builtin_shufflevector(w, w, 0, 1, 2, 3); *(s16x4*)(drow + (size_t)(rr + 1) * L) = __builtin_shufflevector(w, w, 4, 5, 6, 7); } }
    asm volatile("s_waitcnt lgkmcnt(0)" ::: "memory");
}

#define MFMA32(a, b, c) __builtin_amdgcn_mfma_f32_32x32x16_bf16((a), (b), (c), 0, 0, 0)
DI int crow(int i, int h) { return (i & 3) + 8 * (i >> 2) + 4 * h; }
DI f32x16 zero16() { f32x16 z;
#pragma unroll
    for (int i = 0; i < 16; ++i) z[i] = 0.f; return z; }
DI void load_kf(bf16x8 (&kf)[4], const bf16_t* krow) {
#pragma unroll
    for (int s = 0; s < 4; ++s) kf[s] = *(const bf16x8*)(krow + 16 * s);
}
DI f32x16 qk4(const bf16x8 (&kf)[4], const bf16x8 (&qf)[4]) {
    f32x16 st = zero16();
#pragma unroll
    for (int s = 0; s < 4; ++s) st = MFMA32(kf[s], qf[s], st);
    return st;
}
DI f32x16 qk2(const bf16x8& k0, const bf16x8& k1, const bf16x8& q0, const bf16x8& q1) { f32x16 st = zero16(); st = MFMA32(k0, q0, st); st = MFMA32(k1, q1, st); return st; }
DI void load_vf(bf16x8 (&vf)[2][2], const bf16_t* vt, int LD) {
#pragma unroll
    for (int db = 0; db < 2; ++db)
#pragma unroll
        for (int s = 0; s < 2; ++s) { const bf16_t* p = vt + (size_t)db * 32 * LD + 16 * s; const s16x4 a = *(const s16x4*)p; const s16x4 b = *(const s16x4*)(p + 8);
            vf[db][s] = __builtin_shufflevector(a, b, 0, 1, 2, 3, 4, 5, 6, 7); }
}
DI void apply_mask(f32x16& st, int kidx0, int lo, int hi, int h) {
#pragma unroll
    for (int i = 0; i < 16; ++i) { const int kid = kidx0 + crow(i, h); st[i] = (kid >= lo && kid <= hi) ? st[i] : -1e30f; }
}
DI void softmax_pv(f32x16 st, float& m, float& l, f32x16& oa, f32x16& ob, float c, const bf16x8 (&vf)[2][2], float bias = 0.f) {
    float mx = fmaxf(fmaxf(fmaxf(st[0], st[1]), fmaxf(st[2], st[3])), fmaxf(fmaxf(st[4], st[5]), fmaxf(st[6], st[7])));
    mx = fmaxf(mx, fmaxf(fmaxf(fmaxf(st[8], st[9]), fmaxf(st[10], st[11])), fmaxf(fmaxf(st[12], st[13]), fmaxf(st[14], st[15]))));
    mx = fmaxf(mx, __shfl_xor(mx, 32));
    const float mnew = fmaxf(m, mx * c + bias);
    if (__ballot(mnew > m) != 0ull) {
        const float alpha = __builtin_amdgcn_exp2f(m - mnew);
        m = mnew; l *= alpha;
#pragma unroll
        for (int i = 0; i < 16; ++i) { oa[i] *= alpha; ob[i] *= alpha; }
    }
    float rs = 0.f;
    const float nmb = bias - m;
#pragma unroll
    for (int i = 0; i < 16; ++i) { const float p = __builtin_amdgcn_exp2f(__builtin_fmaf(st[i], c, nmb)); st[i] = p; rs += p; }
    rs += __shfl_xor(rs, 32);
    l += rs;
#pragma unroll
    for (int s = 0; s < 2; ++s) {
        u32x4 pw; pw.x = pk2(st[8 * s], st[8 * s + 1]); pw.y = pk2(st[8 * s + 2], st[8 * s + 3]); pw.z = pk2(st[8 * s + 4], st[8 * s + 5]); pw.w = pk2(st[8 * s + 6], st[8 * s + 7]);
        const bf16x8 pb = __builtin_bit_cast(bf16x8, pw);
        oa = MFMA32(vf[0][s], pb, oa); ob = MFMA32(vf[1][s], pb, ob);
    }
}
DI void lds_kf(bf16x8 (&kf)[4], const LAS bf16_t* Kt, int sb, int r, int h) {
#pragma unroll
    for (int s = 0; s < 4; ++s) kf[s] = *(const LAS bf16x8*)(Kt + (32 * sb + r) * 72 + 16 * s + 8 * h);
}
DI void lds_vf(bf16x8 (&vf)[2][2], const LAS bf16_t* Vt, int sb, int r, int h) {
#pragma unroll
    for (int db = 0; db < 2; ++db)
#pragma unroll
        for (int s = 0; s < 2; ++s) { const LAS bf16_t* p = Vt + (32 * db + r) * 72 + 32 * sb + 16 * s + 4 * h; const s16x4 a = *(const LAS s16x4*)p; const s16x4 b = *(const LAS s16x4*)(p + 8);
            vf[db][s] = __builtin_shufflevector(a, b, 0, 1, 2, 3, 4, 5, 6, 7); }
}
#define ATT_BAR() do { asm volatile("s_waitcnt lgkmcnt(0)" ::: "memory"); __builtin_amdgcn_s_barrier(); asm volatile("" ::: "memory"); } while (0)
constexpr int ATT_TILE = 64 * 72;
constexpr int ATT_BUF = 2 * ATT_TILE;
constexpr int ATT_FLAGS = 8 * ATT_TILE * 2;
DI void store_o(bf16_t* orow, const f32x16& oa, const f32x16& ob, float sc, int h) {
#pragma unroll
    for (int g4 = 0; g4 < 4; ++g4) {
        u32x2 w; w.x = pk2(oa[4 * g4] * sc, oa[4 * g4 + 1] * sc); w.y = pk2(oa[4 * g4 + 2] * sc, oa[4 * g4 + 3] * sc);
        *(u32x2*)(orow + 8 * g4 + 4 * h) = w;
        u32x2 w2; w2.x = pk2(ob[4 * g4] * sc, ob[4 * g4 + 1] * sc); w2.y = pk2(ob[4 * g4 + 2] * sc, ob[4 * g4 + 3] * sc);
        *(u32x2*)(orow + 32 + 8 * g4 + 4 * h) = w2;
    }
}
DI void store_o_rows(bf16_t* orow, size_t rstride, const f32x16& oa, const f32x16& ob, float sc, int lane, LAS bf16_t* stg) {
    const int r = lane & 31, h = lane >> 5;
    bf16_t* row0 = orow - (size_t)r * rstride;
#pragma unroll
    for (int g4 = 0; g4 < 4; ++g4) {
        u32x2 w; w.x = pk2(oa[4 * g4] * sc, oa[4 * g4 + 1] * sc); w.y = pk2(oa[4 * g4 + 2] * sc, oa[4 * g4 + 3] * sc);
        *(LAS u32x2*)(stg + r * 72 + 8 * g4 + 4 * h) = w;
        u32x2 w2; w2.x = pk2(ob[4 * g4] * sc, ob[4 * g4 + 1] * sc); w2.y = pk2(ob[4 * g4 + 2] * sc, ob[4 * g4 + 3] * sc);
        *(LAS u32x2*)(stg + r * 72 + 32 + 8 * g4 + 4 * h) = w2;
    }
    asm volatile("s_waitcnt lgkmcnt(0)" ::: "memory");
#pragma unroll
    for (int i = 0; i < 4; ++i) { const int row = (lane >> 3) + 8 * i; const bf16x8 v = *(const LAS bf16x8*)(stg + row * 72 + (lane & 7) * 8);
        *(bf16x8*)(row0 + (size_t)row * rstride + (lane & 7) * 8) = v; }
    asm volatile("s_waitcnt lgkmcnt(0)" ::: "memory");
}
#define O_STG(c) ((LAS bf16_t*)((c).lds + 81920 + (c).wave * 4608))
constexpr int BIGI = 1 << 29;

DI void attn_A_unit(const Ctx& c, int b, int hd, int u, float lam, float lam_init, const float* subln) {
    const int lane = c.lane, r = lane & 31, h = lane >> 5, w = c.wave, qt = 8 * u + w;
    const bf16_t* QKV = (const bf16_t*)(c.p->ws + WS_BIG);
    const size_t tok_q = (size_t)b * SEQ + qt * 32 + r;
    const bf16_t* qrow = QKV + tok_q * NQKV + COL_QA + hd * 64 + 8 * h;
    bf16x8 qf[4];
#pragma unroll
    for (int s = 0; s < 4; ++s) qf[s] = *(const bf16x8*)(qrow + 16 * s);
    const int trow = c.tid >> 3, tch = (c.tid & 7) * 8;
    const bf16_t* kg = QKV + ((size_t)b * SEQ + trow) * NQKV + COL_KA + hd * 64 + tch;
    const bf16_t* vg = (const bf16_t*)(c.p->ws + WS_VT) + ((size_t)(hd * 16 + b) * 64 + trow) * SEQ + tch;
    LAS bf16_t* L = (LAS bf16_t*)c.lds;
    const int loff = trow * 72 + tch;
    float m1 = -1e30f, l1 = 0.f, m2 = -1e30f, l2 = 0.f;
    f32x16 o1a = zero16(), o1b = zero16(), o2a = zero16(), o2b = zero16();
    const float sc = 0.17677669529663687f * LOG2E;
    const int qidx = qt * 32 + r, nt = 4 * u + 4;
    bf16x8 kr = *(const bf16x8*)kg, vr = *(const bf16x8*)vg;
    *(LAS bf16x8*)(L + loff) = kr; *(LAS bf16x8*)(L + ATT_TILE + loff) = vr;
    __syncthreads();
    for (int t = 0; t < nt; ++t) {
        if (t + 1 < nt) { kr = *(const bf16x8*)(kg + (size_t)(t + 1) * 64 * NQKV); vr = *(const bf16x8*)(vg + (t + 1) * 64); }
        const LAS bf16_t* Kt = L + (t & 1) * ATT_BUF; const LAS bf16_t* Vt = Kt + ATT_TILE;
#pragma unroll
        for (int sb = 0; sb < 2; ++sb) {
            const int kb = 2 * t + sb;
            if (kb <= qt) {
                bf16x8 kf[4], vf[2][2]; lds_kf(kf, Kt, sb, r, h); lds_vf(vf, Vt, sb, r, h);
                f32x16 st1 = qk2(kf[0], kf[1], qf[0], qf[1]);
                f32x16 st2 = qk2(kf[2], kf[3], qf[2], qf[3]);
                if (kb == qt) { apply_mask(st1, kb * 32, -BIGI, qidx, h); apply_mask(st2, kb * 32, -BIGI, qidx, h); }
                softmax_pv(st1, m1, l1, o1a, o1b, sc, vf);
                softmax_pv(st2, m2, l2, o2a, o2b, sc, vf);
            }
        }
        if (t + 1 < nt) { LAS bf16_t* Ln = L + ((t + 1) & 1) * ATT_BUF; *(LAS bf16x8*)(Ln + loff) = kr; *(LAS bf16x8*)(Ln + ATT_TILE + loff) = vr; }
        __syncthreads();
    }
    const float i1 = 1.0f / l1, i2 = lam / l2;
    float ss = 0.f;
#pragma unroll
    for (int i = 0; i < 16; ++i) { o1a[i] = o1a[i] * i1 - o2a[i] * i2; o1b[i] = o1b[i] * i1 - o2b[i] * i2; ss += o1a[i] * o1a[i] + o1b[i] * o1b[i]; }
    ss += __shfl_xor(ss, 32);
    const float rn = (1.0f / sqrtf(ss * (1.f / 64.f) + EPS)) * (1.0f - lam_init);
#pragma unroll
    for (int i = 0; i < 16; ++i) { const int dm = crow(i, h); o1a[i] *= subln[dm]; o1b[i] *= subln[32 + dm]; }
    bf16_t* orow = (bf16_t*)(c.p->ws + WS_MIXED) + tok_q * D + hd * 64;
    store_o_rows(orow, D, o1a, o1b, rn, lane, O_STG(c));
}

DI void attn_B_item(const Ctx& c, int br, int b, int hd, int tile) {
    const int lane = c.lane, r = lane & 31, h = lane >> 5;
    const int dsh = 2 * br, d = 1 << dsh, L = SEQ >> dsh, tpr = L >> 5;
    const int rr = tile / tpr, mt = tile % tpr, m0 = mt * 32, mq = m0 + r;
    const bf16_t* QKV = (const bf16_t*)(c.p->ws + WS_BIG);
    const size_t tok_q = (size_t)b * SEQ + mq * d + rr;
    const bf16_t* qrow = QKV + tok_q * NQKV + COL_QB + hd * 64 + 8 * h;
    bf16x8 qf[4];
#pragma unroll
    for (int s = 0; s < 4; ++s) qf[s] = *(const bf16x8*)(qrow + 16 * s);
    const bf16_t* kbase = QKV + ((size_t)b * SEQ + rr + (size_t)r * d) * NQKV + COL_KB + hd * 64 + 8 * h;
    const bf16_t* vt = (const bf16_t*)(c.p->ws + WS_VT) + ((size_t)((10 + hd * 3 + br) * 16 + b) * 64 + r) * SEQ + rr * L + 4 * h;
    float m = -1e30f, l = 0.f; f32x16 oa = zero16(), ob = zero16();
    const float sc = 0.125f * LOG2E;
    int kstart = m0 - 128; if (kstart < 0) kstart = 0;
    bf16x8 kf[4]; load_kf(kf, kbase + (size_t)kstart * d * NQKV);
    bf16x8 vf[2][2]; load_vf(vf, vt + kstart, SEQ);
    for (int kidx0 = kstart; kidx0 <= m0; kidx0 += 32) {
        const int knext = kidx0 < m0 ? kidx0 + 32 : kidx0;
        bf16x8 kn[4]; load_kf(kn, kbase + (size_t)knext * d * NQKV);
        bf16x8 vn[2][2]; load_vf(vn, vt + knext, SEQ);
        f32x16 st = qk4(kf, qf);
        if (kidx0 < m0 - 97 || kidx0 > m0 - 31) apply_mask(st, kidx0, mq - 128, mq, h);
        softmax_pv(st, m, l, oa, ob, sc, vf);
#pragma unroll
        for (int s = 0; s < 4; ++s) kf[s] = kn[s];
#pragma unroll
        for (int a = 0; a < 2; ++a)
#pragma unroll
            for (int s = 0; s < 2; ++s) vf[a][s] = vn[a][s];
    }
    bf16_t* orow = (bf16_t*)(c.p->ws + WS_H) + ((size_t)br * MTOK + tok_q) * 384 + hd * 64;
    store_o(orow, oa, ob, 1.0f / l, h);
    if (h == 0) ((float*)(c.p->ws + WS_LSE))[((size_t)br * MTOK + tok_q) * 6 + hd] = m + __builtin_amdgcn_logf(l);
}

DI void attn_B_unit(const Ctx& c, int br, int b, int hd, int rr, int U) {
    const int lane = c.lane, r = lane & 31, h = lane >> 5, w = c.wave;
    const int dsh = 2 * br, d = 1 << dsh, L = SEQ >> dsh;
    const int mt = 8 * U + w, m0 = 32 * mt, mq = m0 + r;
    const bf16_t* QKV = (const bf16_t*)(c.p->ws + WS_BIG);
    const size_t tok_q = (size_t)b * SEQ + mq * d + rr;
    const bf16_t* qrow = QKV + tok_q * NQKV + COL_QB + hd * 64 + 8 * h;
    bf16x8 qf[4];
#pragma unroll
    for (int s = 0; s < 4; ++s) qf[s] = *(const bf16x8*)(qrow + 16 * s);
    const int trow = c.tid >> 3, tch = (c.tid & 7) * 8;
    const bf16_t* kg = QKV + ((size_t)b * SEQ + rr + (size_t)trow * d) * NQKV + COL_KB + hd * 64 + tch;
    const bf16_t* vg = (const bf16_t*)(c.p->ws + WS_VT) + ((size_t)((10 + hd * 3 + br) * 16 + b) * 64 + trow) * SEQ + rr * L + tch;
    LAS bf16_t* Lb = (LAS bf16_t*)c.lds;
    const int loff = trow * 72 + tch;
    const float sc = 0.125f * LOG2E;
    const int T0 = (4 * U - 2) < 0 ? 0 : (4 * U - 2), T1 = 4 * U + 3, ntile = T1 - T0 + 1;
    bf16x8 kq[6], vq[6];
#pragma unroll
    for (int j = 0; j < 6; ++j) { const int T = (j < ntile) ? T0 + j : T0; kq[j] = *(const bf16x8*)(kg + (size_t)T * 64 * d * NQKV); vq[j] = *(const bf16x8*)(vg + T * 64); }
    ATT_BAR();
#pragma unroll
    for (int j = 0; j < 6; ++j) { *(LAS bf16x8*)(Lb + j * ATT_BUF + loff) = kq[j]; *(LAS bf16x8*)(Lb + j * ATT_BUF + ATT_TILE + loff) = vq[j]; }
    ATT_BAR();
    float m = -1e30f, l = 0.f; f32x16 oa = zero16(), ob = zero16();
    int kb0 = mt - 4; if (kb0 < 0) kb0 = 0;
    for (int kb = kb0; kb <= mt; ++kb) {
        const LAS bf16_t* Kt = Lb + ((kb >> 1) - T0) * ATT_BUF; const LAS bf16_t* Vt = Kt + ATT_TILE;
        bf16x8 kf[4], vf[2][2]; lds_kf(kf, Kt, kb & 1, r, h); lds_vf(vf, Vt, kb & 1, r, h);
        f32x16 st = qk4(kf, qf);
        if (kb == mt - 4 || kb == mt) apply_mask(st, kb * 32, mq - 128, mq, h);
        softmax_pv(st, m, l, oa, ob, sc, vf);
    }
    ATT_BAR();
    bf16_t* orow = (bf16_t*)(c.p->ws + WS_H) + ((size_t)br * MTOK + tok_q) * 384 + hd * 64;
    store_o_rows(orow, (size_t)d * 384, oa, ob, 1.0f / l, lane, O_STG(c));
    if (h == 0) ((float*)(c.p->ws + WS_LSE))[((size_t)br * MTOK + tok_q) * 6 + hd] = m + __builtin_amdgcn_logf(l);
}

DI void attn_B2_unit(const Ctx& c, int b, int hd, int rp) {
    const int lane = c.lane, r = lane & 31, h = lane >> 5, w = c.wave;
    const int ri = w >> 2, mt = w & 3, rr = 2 * rp + ri, m0 = 32 * mt, mq = m0 + r;
    const bf16_t* QKV = (const bf16_t*)(c.p->ws + WS_BIG);
    const size_t tok_q = (size_t)b * SEQ + mq * 16 + rr;
    const bf16_t* qrow = QKV + tok_q * NQKV + COL_QB + hd * 64 + 8 * h;
    bf16x8 qf[4];
#pragma unroll
    for (int s = 0; s < 4; ++s) qf[s] = *(const bf16x8*)(qrow + 16 * s);
    const int trow = c.tid >> 3, tch = (c.tid & 7) * 8;
    LAS bf16_t* Lb = (LAS bf16_t*)c.lds;
    const int loff = trow * 72 + tch;
    bf16x8 kr[4], vr[4];
#pragma unroll
    for (int i = 0; i < 4; ++i) { const int ri2 = i >> 1, kt = i & 1, rr2 = 2 * rp + ri2;
        kr[i] = *(const bf16x8*)(QKV + ((size_t)b * SEQ + rr2 + (size_t)(64 * kt + trow) * 16) * NQKV + COL_KB + hd * 64 + tch);
        vr[i] = *(const bf16x8*)((const bf16_t*)(c.p->ws + WS_VT) + ((size_t)((10 + hd * 3 + 2) * 16 + b) * 64 + trow) * SEQ + rr2 * 128 + 64 * kt + tch); }
#pragma unroll
    for (int i = 0; i < 4; ++i) { *(LAS bf16x8*)(Lb + (2 * i) * ATT_TILE + loff) = kr[i]; *(LAS bf16x8*)(Lb + (2 * i + 1) * ATT_TILE + loff) = vr[i]; }
    __syncthreads();
    float m = -1e30f, l = 0.f; f32x16 oa = zero16(), ob = zero16();
    const float sc = 0.125f * LOG2E;
    for (int kb = 0; kb <= mt; ++kb) {
        const LAS bf16_t* Kt = Lb + (2 * (ri * 2 + (kb >> 1))) * ATT_TILE; const LAS bf16_t* Vt = Kt + ATT_TILE;
        bf16x8 kf[4], vf[2][2]; lds_kf(kf, Kt, kb & 1, r, h); lds_vf(vf, Vt, kb & 1, r, h);
        f32x16 st = qk4(kf, qf);
        if (kb == mt) apply_mask(st, kb * 32, -BIGI, mq, h);
        softmax_pv(st, m, l, oa, ob, sc, vf);
    }
    __syncthreads();
    bf16_t* orow = (bf16_t*)(c.p->ws + WS_H) + ((size_t)2 * MTOK + tok_q) * 384 + hd * 64;
    store_o_rows(orow, (size_t)16 * 384, oa, ob, 1.0f / l, lane, O_STG(c));
    if (h == 0) ((float*)(c.p->ws + WS_LSE))[((size_t)2 * MTOK + tok_q) * 6 + hd] = m + __builtin_amdgcn_logf(l);
}

DI void attn_C_unit(const Ctx& c, int b, int hd, int qb) {
    const int lane = c.lane, r = lane & 31, h = lane >> 5, w = c.wave, qt = 8 * qb + w;
    const bf16_t* QKV = (const bf16_t*)(c.p->ws + WS_BIG);
    const size_t tok_q = (size_t)b * SEQ + qt * 32 + r;
    const bf16_t* qrow = QKV + tok_q * NQKV + COL_QC + hd * 64 + 8 * h;
    bf16x8 qf[4];
#pragma unroll
    for (int s = 0; s < 4; ++s) qf[s] = *(const bf16x8*)(qrow + 16 * s);
    const float* km = (const float*)(c.p->ws + WS_MISC + 4096) + (size_t)(b * 6 + hd) * 8 * 64 + 8 * h;
    float g[7];
#pragma unroll
    for (int n = 0; n < 7; ++n) {
        float dot = 0.f;
        if (n < qb) {
            float d0 = 0.f, d1 = 0.f, d2 = 0.f, d3 = 0.f;
#pragma unroll
            for (int s = 0; s < 4; ++s) { const f32x4 k0 = *(const f32x4*)(km + n * 64 + 16 * s), k1 = *(const f32x4*)(km + n * 64 + 16 * s + 4);
                d0 += bf2f(qf[s][0]) * k0[0] + bf2f(qf[s][4]) * k1[0]; d1 += bf2f(qf[s][1]) * k0[1] + bf2f(qf[s][5]) * k1[1];
                d2 += bf2f(qf[s][2]) * k0[2] + bf2f(qf[s][6]) * k1[2]; d3 += bf2f(qf[s][3]) * k0[3] + bf2f(qf[s][7]) * k1[3]; }
            dot = (d0 + d1) + (d2 + d3);
        }
        dot += __shfl_xor(dot, 32);
        g[n] = (n < qb) ? dot : -__builtin_inff();
    }
    unsigned selmask = 0, wavemask = 0;
#pragma unroll
    for (int n = 0; n < 7; ++n) {
        int cnt = 0;
#pragma unroll
        for (int n2 = 0; n2 < 7; ++n2) if (n2 != n) cnt += (g[n2] > g[n] || (g[n2] == g[n] && n2 < n)) ? 1 : 0;
        const bool sel = (n < qb && cnt < 3);
        if (sel) selmask |= 1u << n;
        if (__ballot(sel) != 0ull) wavemask |= 1u << n;
    }
    LAS int* flags = (LAS int*)(c.lds + ATT_FLAGS);
    if (lane == 0) flags[w] = (int)wavemask;
    __syncthreads();
    unsigned um = 0;
#pragma unroll
    for (int i = 0; i < 8; ++i) um |= (unsigned)flags[i];
    um = __builtin_amdgcn_readfirstlane(um);
    const int nt = 4 + 4 * __builtin_popcount(um);
    const int trow = c.tid >> 3, tch = (c.tid & 7) * 8;
    const bf16_t* kg = QKV + ((size_t)b * SEQ + trow) * NQKV + COL_KC + hd * 64 + tch;
    const bf16_t* vg = (const bf16_t*)(c.p->ws + WS_VT) + ((size_t)((4 + hd) * 16 + b) * 64 + trow) * SEQ + tch;
    LAS bf16_t* L = (LAS bf16_t*)c.lds;
    const int loff = trow * 72 + tch;
    float m = -1e30f, l = 0.f; f32x16 oa = zero16(), ob = zero16();
    const float sc = 0.125f * LOG2E;
    const int qidx = qt * 32 + r;
    const int np = nt >> 1;
    auto pair_tile = [&](int p) -> int { if (p < 2) return 4 * qb + 2 * p; unsigned rr_ = um; for (int i = (p - 2) >> 1; i > 0; --i) rr_ &= rr_ - 1; return 4 * __builtin_ctz(rr_) + 2 * ((p - 2) & 1); };
    int kt = 4 * qb;
    bf16x8 kr0 = *(const bf16x8*)(kg + (size_t)kt * 64 * NQKV), vr0 = *(const bf16x8*)(vg + kt * 64);
    bf16x8 kr1 = *(const bf16x8*)(kg + (size_t)(kt + 1) * 64 * NQKV), vr1 = *(const bf16x8*)(vg + (kt + 1) * 64);
    *(LAS bf16x8*)(L + loff) = kr0; *(LAS bf16x8*)(L + ATT_TILE + loff) = vr0; *(LAS bf16x8*)(L + ATT_BUF + loff) = kr1; *(LAS bf16x8*)(L + ATT_BUF + ATT_TILE + loff) = vr1;
    __syncthreads();
    for (int p = 0; p < np; ++p) {
        int ktn = kt;
        if (p + 1 < np) { ktn = pair_tile(p + 1);
            kr0 = *(const bf16x8*)(kg + (size_t)ktn * 64 * NQKV); vr0 = *(const bf16x8*)(vg + ktn * 64);
            kr1 = *(const bf16x8*)(kg + (size_t)(ktn + 1) * 64 * NQKV); vr1 = *(const bf16x8*)(vg + (ktn + 1) * 64); }
        const LAS bf16_t* G = L + (p & 1) * 2 * ATT_BUF;
        const bool own = p < 2;
        const int nblk = kt >> 2;
        const int mysel = (selmask >> nblk) & 1;
        const bool wave_need = own || (((wavemask >> nblk) & 1) != 0);
        if (wave_need) {
            const float bias = (own || mysel) ? 0.f : -1e30f;
#pragma unroll
            for (int i = 0; i < 2; ++i) {
                const LAS bf16_t* Kt = G + i * ATT_BUF; const LAS bf16_t* Vt = Kt + ATT_TILE;
#pragma unroll
                for (int sb = 0; sb < 2; ++sb) {
                    const int kb = 2 * (kt + i) + sb;
                    if (!own || kb <= qt) {
                        bf16x8 kf[4], vf[2][2]; lds_kf(kf, Kt, sb, r, h); lds_vf(vf, Vt, sb, r, h);
                        f32x16 st = qk4(kf, qf);
                        if (own && kb == qt) apply_mask(st, kb * 32, -BIGI, qidx, h);
                        softmax_pv(st, m, l, oa, ob, sc, vf, bias);
                    }
                }
            }
        }
        if (p + 1 < np) { LAS bf16_t* Gn = L + ((p + 1) & 1) * 2 * ATT_BUF;
            *(LAS bf16x8*)(Gn + loff) = kr0; *(LAS bf16x8*)(Gn + ATT_TILE + loff) = vr0; *(LAS bf16x8*)(Gn + ATT_BUF + loff) = kr1; *(LAS bf16x8*)(Gn + ATT_BUF + ATT_TILE + loff) = vr1; }
        __syncthreads();
        kt = ktn;
    }
    bf16_t* orow = (bf16_t*)(c.p->ws + WS_MIXED) + tok_q * D + 640 + hd * 64;
    store_o_rows(orow, D, oa, ob, 1.0f / l, lane, O_STG(c));
}

DI void attn_M_item(const Ctx& c, int b, int hd, int qt) {
    const int lane = c.lane, r = lane & 31, h = lane >> 5;
    const unsigned char* big = c.p->ws + WS_BIG;
    const size_t tok_q = (size_t)b * SEQ + qt * 32 + r;
    const bf16_t* qrow = (const bf16_t*)(big + BIG_QM) + tok_q * 256 + hd * 64 + 8 * h;
    bf16x8 qf[4];
#pragma unroll
    for (int s = 0; s < 4; ++s) qf[s] = *(const bf16x8*)(qrow + 16 * s);
    const bf16_t* kbase = (const bf16_t*)(c.p->ws + WS_KVM) + ((size_t)b * MEMLEN + r) * 512 + hd * 64 + 8 * h;
    const bf16_t* vt = (const bf16_t*)(c.p->ws + WS_VTM) + ((size_t)(b * 4 + hd) * 64 + r) * MEMLEN + 4 * h;
    float m = -1e30f, l = 0.f; f32x16 oa = zero16(), ob = zero16();
    const float sc = 0.125f * LOG2E;
    bf16x8 kf[4]; load_kf(kf, kbase);
    for (int kb = 0; kb < 8; ++kb) {
        const int kidx0 = kb * 32;
        bf16x8 vf[2][2]; load_vf(vf, vt + kidx0, MEMLEN);
        bf16x8 kn[4]; load_kf(kn, kbase + (size_t)(kb < 7 ? kidx0 + 32 : kidx0) * 512);
        const f32x16 st = qk4(kf, qf);
        softmax_pv(st, m, l, oa, ob, sc, vf);
#pragma unroll
        for (int s = 0; s < 4; ++s) kf[s] = kn[s];
    }
    bf16_t* orow = (bf16_t*)(big + BIG_OM) + tok_q * 256 + hd * 64;
    store_o_rows(orow, 256, oa, ob, 1.0f / l, lane, O_STG(c));
}

DI void attn_M_unit(const Ctx& c, int b, int hd, int u) {
    const int lane = c.lane, r = lane & 31, h = lane >> 5, w = c.wave, qt = 8 * u + w;
    const unsigned char* big = c.p->ws + WS_BIG;
    const size_t tok_q = (size_t)b * SEQ + qt * 32 + r;
    const bf16_t* qrow = (const bf16_t*)(big + BIG_QM) + tok_q * 256 + hd * 64 + 8 * h;
    bf16x8 qf[4];
#pragma unroll
    for (int s = 0; s < 4; ++s) qf[s] = *(const bf16x8*)(qrow + 16 * s);
    const int trow = c.tid >> 3, tch = (c.tid & 7) * 8;
    LAS bf16_t* Lb = (LAS bf16_t*)c.lds;
    const int loff = trow * 72 + tch;
    bf16x8 kr[4], vr[4];
#pragma unroll
    for (int i = 0; i < 4; ++i) {
        kr[i] = *(const bf16x8*)((const bf16_t*)(c.p->ws + WS_KVM) + ((size_t)b * MEMLEN + 64 * i + trow) * 512 + hd * 64 + tch);
        vr[i] = *(const bf16x8*)((const bf16_t*)(c.p->ws + WS_VTM) + ((size_t)(b * 4 + hd) * 64 + trow) * MEMLEN + 64 * i + tch); }
    ATT_BAR();
#pragma unroll
    for (int i = 0; i < 4; ++i) { *(LAS bf16x8*)(Lb + (2 * i) * ATT_TILE + loff) = kr[i]; *(LAS bf16x8*)(Lb + (2 * i + 1) * ATT_TILE + loff) = vr[i]; }
    ATT_BAR();
    float m = -1e30f, l = 0.f; f32x16 oa = zero16(), ob = zero16();
    const float sc = 0.125f * LOG2E;
    for (int kb = 0; kb < 8; ++kb) {
        const LAS bf16_t* Kt = Lb + (2 * (kb >> 1)) * ATT_TILE; const LAS bf16_t* Vt = Kt + ATT_TILE;
        bf16x8 kf[4], vf[2][2]; lds_kf(kf, Kt, kb & 1, r, h); lds_vf(vf, Vt, kb & 1, r, h);
        const f32x16 st = qk4(kf, qf);
        softmax_pv(st, m, l, oa, ob, sc, vf);
    }
    bf16_t* orow = (bf16_t*)(big + BIG_OM) + tok_q * 256 + hd * 64;
    store_o_rows(orow, 256, oa, ob, 1.0f / l, lane, O_STG(c));
}

constexpr int PH_CONV = 0, PH_GU1 = 1, PH_DN1 = 2, PH_WIN = 3, PH_POST = 4, PH_ATT = 5, PH_MERGE = 6, PH_WOUT = 7, PH_MQ = 8, PH_MATT = 9,
              PH_MO = 10, PH_GU2 = 11, PH_DN2 = 12, PH_PER_LAYER = 13, PH_FINAL = 2 * PH_PER_LAYER, PH_TOTAL = PH_FINAL + 1;

DI float lam_init_of(int l) { return l == 0 ? 0.2f : 0.8f - 0.6f * 0.7408182206817179f; }
DI float* ssq_buf(unsigned char* ws, int l, int k) { return (float*)(ws + WS_SSQ) + (size_t)(l * 4 + k) * MTOK; }

DI void phase_conv(const Ctx& c) {
    CParams& P = *c.p; const int l = c.l;
    bf16_t* Wb = (bf16_t*)(P.ws + WS_W);
    LAS float* scr = (LAS float*)(c.lds + c.wave * 8448);
    constexpr int I_G = (D / 64) * (FF / 32), I_D = (FF / 64) * (D / 32), I_IN = (D / 64) * (NQKV / 32), I_OUT = (D / 64) * (D / 32), I_MQ = (D / 64) * (256 / 32),
                  I_MKV = (D / 64) * (512 / 32), I_MO = (256 / 64) * (D / 32);
    constexpr int NITEMS = 4 * I_G + 2 * I_D + I_IN + I_OUT + I_MQ + I_MKV + I_MO;
    const float* g1 = P.in[3] + (size_t)l * D; const float* g2 = P.in[20] + (size_t)l * D; const float* gm = P.in[7] + (size_t)l * D; const float* gq = P.in[15] + (size_t)l * D;
    for (int it = c.gw; it < NITEMS; it += c.ngw) {
        int r = it;
        if (r < I_G) { transpose_item(P.in[4] + (size_t)l * D * FF, D, FF, Wb + W_GU1, 3, 0, scr, r, c.lane, g1); continue; } r -= I_G;
        if (r < I_G) { transpose_item(P.in[5] + (size_t)l * D * FF, D, FF, Wb + W_GU1, 3, 4, scr, r, c.lane, g1); continue; } r -= I_G;
        if (r < I_D) { transpose_item(P.in[6] + (size_t)l * D * FF, FF, D, Wb + W_DN1, 2, 0, scr, r, c.lane); continue; } r -= I_D;
        if (r < I_G) { transpose_item(P.in[21] + (size_t)l * D * FF, D, FF, Wb + W_GU2, 3, 0, scr, r, c.lane, g2); continue; } r -= I_G;
        if (r < I_G) { transpose_item(P.in[22] + (size_t)l * D * FF, D, FF, Wb + W_GU2, 3, 4, scr, r, c.lane, g2); continue; } r -= I_G;
        if (r < I_D) { transpose_item(P.in[23] + (size_t)l * D * FF, FF, D, Wb + W_DN2, 2, 0, scr, r, c.lane); continue; } r -= I_D;
        if (r < I_IN) { transpose_item(P.in[8] + (size_t)l * D * NQKV, D, NQKV, Wb + W_IN, 2, 0, scr, r, c.lane, gm); continue; } r -= I_IN;
        if (r < I_OUT) { transpose_item(P.in[9] + (size_t)l * D * D, D, D, Wb + W_OUT, 2, 0, scr, r, c.lane); continue; } r -= I_OUT;
        if (r < I_MQ) { transpose_item(P.in[17] + (size_t)l * D * 256, D, 256, Wb + W_MQ, 2, 0, scr, r, c.lane, gq); continue; } r -= I_MQ;
        if (r < I_MKV) { transpose_item(P.in[18] + (size_t)l * D * 512, D, 512, Wb + W_MKV, 2, 0, scr, r, c.lane); continue; } r -= I_MKV;
        transpose_item(P.in[19] + (size_t)l * 256 * D, 256, D, Wb + W_MO, 2, 0, scr, r, c.lane);
    }
    norm_phase(c, P.in[1], P.in[16] + (size_t)l * D, (bf16_t*)(P.ws + WS_MEMN), MROWS);
    if (l == 0) {
        bf16_t* XB = (bf16_t*)(P.ws + WS_H); float* ssq0 = ssq_buf(P.ws, 0, 0);
        for (int m = c.gw; m < MTOK; m += c.ngw) {
            const f32x4* xr = (const f32x4*)(P.in[0] + (size_t)m * D) + c.lane; u32x2* o8 = (u32x2*)(XB + (size_t)m * D) + c.lane; float sq = 0.f;
#pragma unroll
            for (int j = 0; j < 4; ++j) { const f32x4 v = xr[64 * j]; sq += (v.x * v.x + v.y * v.y) + (v.z * v.z + v.w * v.w); u32x2 w; w.x = pk2(v.x, v.y); w.y = pk2(v.z, v.w); o8[64 * j] = w; }
            sq = wave_sum(sq); if (c.lane == 0) ssq0[m] = sq;
        }
        const int gt = c.bid * 512 + c.tid, ngt = c.G * 512;
        for (int i = gt; i < 7 * MTOK; i += ngt) ssq0[MTOK + i] = 0.f;
        const int* pos = (const int*)P.in[2];
        float* cosH = (float*)(P.ws + WS_COSH); float* sinH = (float*)(P.ws + WS_SINH); float* cosA = (float*)(P.ws + WS_COSA); float* sinA = (float*)(P.ws + WS_SINA);
        for (int i = gt; i < MTOK * 8; i += ngt) { const int t = i >> 3, f = i & 7; const float invf = powf(500000.0f, -(float)(2 * f) / 16.0f); const float ang = (float)pos[t] * invf;
            float sn, cs; sincosf(ang, &sn, &cs); cosH[i] = cs; sinH[i] = sn; }
        for (int i = gt; i < MTOK * 4; i += ngt) { const int t = i >> 2, f = i & 3; const float invf = powf(500000.0f, -(float)(2 * f) / 8.0f); const float ang = (float)pos[t] * invf;
            float sn, cs; sincosf(ang, &sn, &cs); cosA[i] = cs; sinA[i] = sn; }
        if (c.bid == 0 && c.wave == 0) {
            unsigned* cnt = (unsigned*)(P.ws + WS_MISC);
            cnt[c.lane] = 0u;
            float* lamp = (float*)(P.ws + WS_MISC + 256);
            for (int ll = 0; ll < 2; ++ll) {
                float a = 0.f, bsum = 0.f;
                if (c.lane < 32) { a = P.in[10][ll * 32 + c.lane] * P.in[11][ll * 32 + c.lane]; bsum = P.in[12][ll * 32 + c.lane] * P.in[13][ll * 32 + c.lane]; }
                a = wave_sum(a); bsum = wave_sum(bsum);
                if (c.lane == 0) lamp[ll] = expf(a) - expf(bsum) + lam_init_of(ll);
            }
        }
    }
}

DI void kmean_item(const Ctx& c, int item) {
    CParams& P = *c.p; const int lane = c.lane;
    const int qr = item & 3, it4 = item >> 2, hd = it4 >> 7, tb = it4 & 127, tok0 = tb * 256 + qr * 64;
    bf16_t* base = (bf16_t*)(P.ws + WS_BIG) + (size_t)tok0 * NQKV + COL_KC + hd * 64 + lane;
    const float* cosT = (const float*)(P.ws + WS_COSH); const float* sinT = (const float*)(P.ws + WS_SINH);
    const bool rot = lane < 16, first = lane < 8; const int fi = lane & 7;
    float sum = 0.f;
    for (int t0 = 0; t0 < 64; t0 += 16) {
        float own[16], cs[16], sn[16];
#pragma unroll
        for (int j = 0; j < 16; ++j) { own[j] = bfu2f(base[(size_t)(t0 + j) * NQKV]); cs[j] = rot ? cosT[(size_t)(tok0 + t0 + j) * 8 + fi] : 1.f; sn[j] = rot ? sinT[(size_t)(tok0 + t0 + j) * 8 + fi] : 0.f; }
#pragma unroll
        for (int j = 0; j < 16; ++j) {
            const float par = __shfl_xor(own[j], 8);
            float v = own[j];
            if (rot) { v = first ? (own[j] * cs[j] - par * sn[j]) : (own[j] * cs[j] + par * sn[j]); base[(size_t)(t0 + j) * NQKV] = f2bf(v); }
            sum += v;
        }
    }
    const int b = tb >> 3, n = tb & 7; atomicAdd((float*)(P.ws + WS_MISC + 4096) + ((size_t)(b * 6 + hd) * 8 + n) * 64 + lane, sum * (1.0f / 256.0f));
}

DI void rot_fast(const Ctx& c) {
    CParams& P = *c.p;
    bf16_t* QKV = (bf16_t*)(P.ws + WS_BIG);
    const float* cosH = (const float*)(P.ws + WS_COSH); const float* sinH = (const float*)(P.ws + WS_SINH); const float* cosA = (const float*)(P.ws + WS_COSA); const float* sinA = (const float*)(P.ws + WS_SINA);
    const int gt = c.bid * 512 + c.tid, ngt = c.G * 512;
    for (int i0 = gt; i0 < MTOK * 18; i0 += 4 * ngt) {
        bf16x8 a[4], b[4]; f32x4 c0[4], c1[4], s0[4], s1[4]; bf16_t* pp[4];
#pragma unroll
        for (int u = 0; u < 4; ++u) { const int i = i0 + u * ngt; const bool ok = i < MTOK * 18; const int ii = ok ? i : 0; const int tok = ii / 18, sl = ii % 18;
            const int col = sl < 6 ? COL_QB + sl * 64 : (sl < 12 ? COL_KB + (sl - 6) * 64 : COL_QC + (sl - 12) * 64);
            pp[u] = ok ? QKV + (size_t)tok * NQKV + col : nullptr;
            a[u] = *(const bf16x8*)(QKV + (size_t)tok * NQKV + col); b[u] = *(const bf16x8*)(QKV + (size_t)tok * NQKV + col + 8);
            const f32x4* cp = (const f32x4*)(cosH + (size_t)tok * 8); const f32x4* sp = (const f32x4*)(sinH + (size_t)tok * 8);
            c0[u] = cp[0]; c1[u] = cp[1]; s0[u] = sp[0]; s1[u] = sp[1]; }
#pragma unroll
        for (int u = 0; u < 4; ++u) {
            float o1[8], o2[8];
#pragma unroll
            for (int j = 0; j < 8; ++j) { const float x1 = bf2f(a[u][j]), x2 = bf2f(b[u][j]); const float cs = j < 4 ? c0[u][j & 3] : c1[u][j & 3], sn = j < 4 ? s0[u][j & 3] : s1[u][j & 3];
                o1[j] = x1 * cs - x2 * sn; o2[j] = x2 * cs + x1 * sn; }
            u32x4 w1, w2; w1.x = pk2(o1[0], o1[1]); w1.y = pk2(o1[2], o1[3]); w1.z = pk2(o1[4], o1[5]); w1.w = pk2(o1[6], o1[7]);
            w2.x = pk2(o2[0], o2[1]); w2.y = pk2(o2[2], o2[3]); w2.z = pk2(o2[4], o2[5]); w2.w = pk2(o2[6], o2[7]);
            if (pp[u]) { *(u32x4*)pp[u] = w1; *(u32x4*)(pp[u] + 8) = w2; }
        }
    }
    for (int i0 = gt; i0 < MTOK * 16; i0 += 4 * ngt) {
        bf16x8 a[4]; f32x4 c0[4], s0[4]; bf16_t* pp[4];
#pragma unroll
        for (int u = 0; u < 4; ++u) { const int i = i0 + u * ngt; const bool ok = i < MTOK * 16; const int ii = ok ? i : 0; const int tok = ii >> 4, sl = ii & 15;
            pp[u] = ok ? QKV + (size_t)tok * NQKV + sl * 32 : nullptr;
            a[u] = *(const bf16x8*)(QKV + (size_t)tok * NQKV + sl * 32);
            c0[u] = *(const f32x4*)(cosA + (size_t)tok * 4); s0[u] = *(const f32x4*)(sinA + (size_t)tok * 4); }
#pragma unroll
        for (int u = 0; u < 4; ++u) {
            float o[8];
#pragma unroll
            for (int j = 0; j < 4; ++j) { const float x1 = bf2f(a[u][j]), x2 = bf2f(a[u][4 + j]); o[j] = x1 * c0[u][j] - x2 * s0[u][j]; o[4 + j] = x2 * c0[u][j] + x1 * s0[u][j]; }
            u32x4 w; w.x = pk2(o[0], o[1]); w.y = pk2(o[2], o[3]); w.z = pk2(o[4], o[5]); w.w = pk2(o[6], o[7]);
            if (pp[u]) *(u32x4*)pp[u] = w;
        }
    }
}

DI void phase_post(const Ctx& c) {
    CParams& P = *c.p;
    constexpr int N_KM = 4 * 6 * 128, N_VT = 16 * 16 * 32;
    LAS bf16_t* tile = (LAS bf16_t*)(c.lds + c.wave * 9216);
    const bf16_t* QKV = (const bf16_t*)(P.ws + WS_BIG);
    for (int it = c.gw; it < N_KM + N_VT; it += c.ngw) {
        if (it < N_KM) { kmean_item(c, it); continue; }
        const int v = it - N_KM; const int sl = v / 512, rem = v % 512, b = rem >> 5, t0 = (rem & 31) * 64;
        bf16x8 vv[8];
        if (sl < 6) {
            vt_load(vv, QKV + ((size_t)b * SEQ + t0) * NQKV + COL_VB + sl * 64, NQKV, c.lane);
#pragma unroll
            for (int br = 0; br < 3; ++br) vt_item(vv, (bf16_t*)(P.ws + WS_VT) + (size_t)((10 + sl * 3 + br) * 16 + b) * 64 * SEQ, SEQ, t0, 2 * br, SEQ >> (2 * br), tile, c.lane);
        } else {
            const int slot = sl - 6; const int col = slot < 4 ? COL_VA + slot * 64 : COL_VC + (slot - 4) * 64;
            vt_load(vv, QKV + ((size_t)b * SEQ + t0) * NQKV + col, NQKV, c.lane);
            vt_item(vv, (bf16_t*)(P.ws + WS_VT) + (size_t)(slot * 16 + b) * 64 * SEQ, SEQ, t0, 0, SEQ, tile, c.lane);
        }
    }
    rot_fast(c);
}

DI void phase_att(const Ctx& c) {
    CParams& P = *c.p; const int l = c.l;
    unsigned* cnt = (unsigned*)(P.ws + WS_MISC) + 2 * l;
    const float lam = ((const float*)(P.ws + WS_MISC + 256))[l];
    const float lam_init = lam_init_of(l);
    const float* subln = P.in[14] + l * 64;
    LAS int* slot = (LAS int*)(c.lds + ATT_FLAGS + 64);
    for (;;) {
        if (c.tid == 0) slot[0] = (int)atomicAdd(cnt, 1u);
        __syncthreads();
        const int it = __builtin_amdgcn_readfirstlane(slot[0]);
        __syncthreads();
        if (it >= 8 * 160 + 3 * 768) break;
        if (it < 8 * 160) {
            const int lev = 7 - it / 160, sub = it % 160;
            if (sub < 64) attn_A_unit(c, sub >> 2, sub & 3, lev, lam, lam_init, subln);
            else { const int s2 = sub - 64; attn_C_unit(c, s2 / 6, s2 % 6, lev); }
        } else {
            const int v0 = it - 8 * 160; const int br = v0 / 768, v = v0 % 768; const int b = v / 48, rem = v % 48, hd = rem >> 3, x = rem & 7;
            if (br < 2) attn_B_unit(c, br, b, hd, br == 0 ? 0 : (x >> 1), br == 0 ? x : (x & 1));
            else attn_B2_unit(c, b, hd, x);
        }
    }
#if 0
    constexpr int N2 = 16 * 6 * 64;
    for (;;) {
        int it = 0;
        if (c.lane == 0) it = (int)atomicAdd(cnt + 1, 1u);
        it = __builtin_amdgcn_readfirstlane(it);
        if (it >= N2) break;
        const int tile = it & 63, rest = it >> 6; const int hd = rest % 6, b = rest / 6;
        attn_B_item(c, 2, b, hd, tile);
    }
#endif
}

DI void phase_merge(const Ctx& c) {
    CParams& P = *c.p;
    const bf16_t* part = (const bf16_t*)(P.ws + WS_H); const float* lse = (const float*)(P.ws + WS_LSE); bf16_t* mixed = (bf16_t*)(P.ws + WS_MIXED);
    const int gt = c.bid * 512 + c.tid, ngt = c.G * 512;
    constexpr int NI = MTOK * 48;
    for (int i0 = gt; i0 < NI; i0 += 4 * ngt) {
        float lv[4][3]; bf16x8 pv[4][3]; bf16_t* dst[4];
#pragma unroll
        for (int u = 0; u < 4; ++u) { const int i = i0 + u * ngt; const bool ok = i < NI; const int ii = ok ? i : 0; const int tok = ii / 48, rem = ii % 48, hd = rem >> 3, g8 = rem & 7;
            dst[u] = ok ? mixed + (size_t)tok * D + 256 + hd * 64 + g8 * 8 : nullptr;
#pragma unroll
            for (int k = 0; k < 3; ++k) { lv[u][k] = lse[((size_t)k * MTOK + tok) * 6 + hd]; pv[u][k] = *(const bf16x8*)(part + ((size_t)k * MTOK + tok) * 384 + hd * 64 + g8 * 8); } }
#pragma unroll
        for (int u = 0; u < 4; ++u) {
            const float mx = fmaxf(lv[u][0], fmaxf(lv[u][1], lv[u][2]));
            float w0 = __builtin_amdgcn_exp2f(lv[u][0] - mx), w1 = __builtin_amdgcn_exp2f(lv[u][1] - mx), w2 = __builtin_amdgcn_exp2f(lv[u][2] - mx);
            const float inv = 1.0f / (w0 + w1 + w2); w0 *= inv; w1 *= inv; w2 *= inv;
            float o[8];
#pragma unroll
            for (int j = 0; j < 8; ++j) o[j] = w0 * bf2f(pv[u][0][j]) + w1 * bf2f(pv[u][1][j]) + w2 * bf2f(pv[u][2][j]);
            u32x4 w; w.x = pk2(o[0], o[1]); w.y = pk2(o[2], o[3]); w.z = pk2(o[4], o[5]); w.w = pk2(o[6], o[7]);
            if (dst[u]) *(u32x4*)dst[u] = w;
        }
    }
}

template <class Epi> DI void run_gemm(const Ctx& c, const bf16_t* A, const bf16_t* Bt, int M, int N, int K, const Epi& E, int off = 0) {
    pg8::Gemm g{A, Bt, M, N, K}; pg8::StaticOrder S; S.init(M, N, c.G, (c.bid + c.G - off) % c.G);
    pg8::gemm_phase<Epi, pg8::StaticOrder>(c.lds, g, S, E, c.tid);
}

__global__ void __launch_bounds__(512, 2) mega(Params Parg) {
    extern __shared__ __attribute__((aligned(16))) unsigned char lds_raw[];
    cg::grid_group grid = cg::this_grid();
    const int ph_lo = Parg.lo, ph_hi = Parg.hi;
#ifdef PROBE_MASK
    unsigned long long tacc = 0, tstart = 0; int qprev = -1;
#endif
    unsigned bar_gen = 0;
    for (int ph = ph_lo; ph < ph_hi; ++ph) {
        if (ph == ph_lo + 1) grid.sync();
        else if (ph != ph_lo) grid_barrier((unsigned*)(Parg.ws + WS_BAR), gridDim.x, bar_gen);
#ifdef PROBE_MASK
        { const unsigned long long tn = __builtin_amdgcn_s_memrealtime(); if (qprev >= 0 && ((PROBE_MASK >> qprev) & 1)) tacc += tn - tstart; tstart = tn; qprev = (ph == PH_FINAL) ? -1 : ph % PH_PER_LAYER; }
#endif
        int tid_l = threadIdx.x; asm volatile("" : "+v"(tid_l));
        unsigned long long kpu = (unsigned long long)__builtin_amdgcn_kernarg_segment_ptr(); asm volatile("" : "+s"(kpu));
        Ctx c; c.p = (CParams*)kpu; c.tid = tid_l; c.lane = c.tid & 63; c.wave = __builtin_amdgcn_readfirstlane(c.tid >> 6);
        int G_l = gridDim.x, bid_l = blockIdx.x; asm volatile("" : "+s"(G_l), "+s"(bid_l));
        c.G = G_l; c.bid = bid_l; c.gw = c.bid * 8 + c.wave; c.ngw = c.G * 8; c.lds = (LAS unsigned char*)lds_raw;
#define PHASE_BEGIN unsigned long long kpl_ = kpu; asm volatile("" : "+s"(kpl_)); c.p = (CParams*)kpl_; CParams& P = *c.p; unsigned char* ws = P.ws; \
        bf16_t* Wb = (bf16_t*)(ws + WS_W); bf16_t* XB = (bf16_t*)(ws + WS_H); bf16_t* ACT = (bf16_t*)(ws + WS_BIG); bf16_t* MIXED = (bf16_t*)(ws + WS_MIXED); (void)Wb; (void)XB; (void)ACT; (void)MIXED;
        if (ph == PH_FINAL) {
            PHASE_BEGIN
            for (int m = c.gw; m < MTOK; m += c.ngw) norm_row_f32(P.out + (size_t)m * D, P.in[24], P.out + (size_t)m * D, c.lane);
            continue;
        }
        const int l = ph / PH_PER_LAYER, q = ph % PH_PER_LAYER; c.l = l;
        switch (q) {
        case PH_CONV: { PHASE_BEGIN phase_conv(c); } break;
        case PH_GU1: { PHASE_BEGIN pg8::EpiSwiglu E{ACT, ssq_buf(ws, l, 0)}; run_gemm(c, XB, Wb + W_GU1, MTOK, 2 * FF, D, E); } break;
        case PH_DN1: { PHASE_BEGIN pg8::EpiResid E{(l == 0) ? P.in[0] : P.out, P.out, 0.5f, XB, ssq_buf(ws, l, 1)}; run_gemm(c, ACT, Wb + W_DN1, MTOK, D, FF, E); } break;
        case PH_WIN: { PHASE_BEGIN
            { float* kmz = (float*)(ws + WS_MISC + 4096); for (int i = c.bid * 512 + c.tid; i < 16 * 6 * 8 * 64; i += c.G * 512) kmz[i] = 0.f; }
            pg8::EpiStore E{ACT, NQKV, ssq_buf(ws, l, 1)}; run_gemm(c, XB, Wb + W_IN, MTOK, NQKV, D, E); } break;
        case PH_POST: { PHASE_BEGIN phase_post(c); } break;
        case PH_ATT: { PHASE_BEGIN phase_att(c); } break;
        case PH_MERGE: { PHASE_BEGIN phase_merge(c); } break;
        case PH_WOUT: { PHASE_BEGIN pg8::EpiResid E{P.out, P.out, 1.0f, XB, ssq_buf(ws, l, 2)}; run_gemm(c, MIXED, Wb + W_OUT, MTOK, D, D, E); } break;
        case PH_MQ: { PHASE_BEGIN
            pg8::EpiStore E{(bf16_t*)(ws + WS_BIG + BIG_QM), 256, ssq_buf(ws, l, 2)}; run_gemm(c, XB, Wb + W_MQ, MTOK, 256, D, E);
            pg8::EpiStoreKV E2{(bf16_t*)(ws + WS_KVM), (bf16_t*)(ws + WS_VTM)}; run_gemm(c, (const bf16_t*)(ws + WS_MEMN), Wb + W_MKV, MROWS, 512, D, E2, 128);
        } break;
        case PH_MATT: { PHASE_BEGIN } for (int v = c.bid; v < 16 * 4 * 8; v += c.G) attn_M_unit(c, v >> 5, (v >> 3) & 3, v & 7); break;
        case PH_MO: { PHASE_BEGIN pg8::EpiResid E{P.out, P.out, 1.0f, XB, ssq_buf(ws, l, 3)}; run_gemm(c, (const bf16_t*)(ws + WS_BIG + BIG_OM), Wb + W_MO, MTOK, D, 256, E); } break;
        case PH_GU2: { PHASE_BEGIN pg8::EpiSwiglu E{ACT, ssq_buf(ws, l, 3)}; run_gemm(c, XB, Wb + W_GU2, MTOK, 2 * FF, D, E); } break;
        case PH_DN2: { PHASE_BEGIN pg8::EpiResid E{P.out, P.out, 0.5f, (l == 0) ? XB : nullptr, (l == 0) ? ssq_buf(ws, 1, 0) : nullptr}; run_gemm(c, ACT, Wb + W_DN2, MTOK, D, FF, E); } break;
        default: break;
        }
    }
#ifdef PROBE_MASK
    if (blockIdx.x == 0) { const unsigned long long tend = __builtin_amdgcn_s_memrealtime() + tacc * PROBE_MULT; while (__builtin_amdgcn_s_memrealtime() < tend) __builtin_amdgcn_s_sleep(32); }
#endif
}

constexpr int LDS_BYTES = 135168;

extern "C" void kernel_launch(void* const* d_in, const int* in_sizes, int n_in, void* d_out, int out_size, void* d_ws, size_t ws_size, hipStream_t stream) {
    static int grid = 0;
    if (grid == 0) {
        if (n_in != 25 || out_size != MTOK * D || ws_size < WS_END) { fprintf(stderr, "kernel_launch: unexpected shapes (n_in %d out %d ws %zu)\n", n_in, out_size, ws_size); grid = -1; return; }
        int dev = 0, cus = 0, per_cu = 0;
        hipGetDevice(&dev);
        hipDeviceGetAttribute(&cus, hipDeviceAttributeMultiprocessorCount, dev);
        if (hipFuncSetAttribute((const void*)mega, hipFuncAttributeMaxDynamicSharedMemorySize, LDS_BYTES) != hipSuccess) { fprintf(stderr, "kernel_launch: hipFuncSetAttribute failed\n"); grid = -1; return; }
        if (hipOccupancyMaxActiveBlocksPerMultiprocessor(&per_cu, (const void*)mega, 512, LDS_BYTES) != hipSuccess || per_cu < 1) { fprintf(stderr, "kernel_launch: occupancy query gave %d\n", per_cu); per_cu = 1; }
        (void)hipGetLastError();
        grid = cus * per_cu;
    }
    if (grid < 0) return;
    if (hipMemsetAsync((char*)d_ws + WS_BAR, 0, 1024, stream) != hipSuccess) { fprintf(stderr, "kernel_launch: memset failed\n"); return; }
    Params p{};
    for (int i = 0; i < 25; ++i) p.in[i] = (const float*)d_in[i];
    p.out = (float*)d_out; p.ws = (unsigned char*)d_ws;
#ifdef MK_PER_PHASE
    for (int ph = 0; ph < PH_TOTAL; ++ph) { p.lo = ph; p.hi = ph + 1; hipLaunchKernelGGL(mega, dim3(grid), dim3(512), LDS_BYTES, stream, p); }
#else
    p.lo = 0; p.hi = PH_TOTAL;
    void* args[] = {&p};
    hipError_t e = hipLaunchCooperativeKernel((const void*)mega, dim3(grid), dim3(512), args, LDS_BYTES, stream);
    if (e != hipSuccess) fprintf(stderr, "cooperative launch failed: %s (grid %d)\n", hipGetErrorString(e), grid);
#endif
}
```
